# Optimizing an MI355X kernel written in HIP

```python
import math
import jax, jax.numpy as jnp
from jax import lax
import numpy as np


D_MODEL = 2048
BATCH = 1
SEQ = 8192
DEPTH = 2
DEC_BATCH = 8
DEC_SEQ = 2048
PAST_LEN = 128

D_MIX = D_MODEL
D_ATTN = D_MIX // 2
D_HYENA = D_MIX - D_ATTN
HEAD_DIM = 64
N_HEADS = D_ATTN // HEAD_DIM
N_KV_HEADS = N_HEADS // 4
GQA_GROUPS = N_HEADS // N_KV_HEADS
ROT_DIM = HEAD_DIM // 4
ROPE_THETA = 500000.0
WINDOW = 128
BLOCK = 128
HYENA_ORDER = 2
FILTER_BANDS = 16
FILTER_EMB = 2 * FILTER_BANDS + 1
FILTER_HIDDEN = 64
N_FILTERS = HYENA_ORDER * 2 * D_HYENA
DECAY_SLOW = -math.log(1e-2) / 1.5
DECAY_FAST = -math.log(1e-2) / 0.3
DN_ALPHA = (2.0 * DEPTH) ** 0.25
DN_BETA = (8.0 * DEPTH) ** -0.25
NORM_EPS = 1e-5
MASK_VALUE = -1e30
Q_COLS = N_HEADS * HEAD_DIM
KV_COLS = N_KV_HEADS * HEAD_DIM
SECTION_SIZES = (Q_COLS, KV_COLS, KV_COLS, D_ATTN, 3 * D_HYENA, D_HYENA)
SPLIT_POINTS = tuple(sum(SECTION_SIZES[:i + 1]) for i in range(len(SECTION_SIZES) - 1))
D_IN = sum(SECTION_SIZES)
V_START = Q_COLS + KV_COLS
HYV_START = Q_COLS + 2 * KV_COLS + D_ATTN

kernel_name = 'hymba_swa_hyena_bidir_encoder'


def _layernorm(t, g, b):
    tf = t.astype(jnp.float32)
    mu = jnp.mean(tf, axis=-1, keepdims=True)
    var = jnp.mean(jnp.square(tf - mu), axis=-1, keepdims=True)
    return ((tf - mu) * lax.rsqrt(var + NORM_EPS) * g + b).astype(t.dtype)


def _rmsnorm(t, g):
    tf = t.astype(jnp.float32)
    return (tf * lax.rsqrt(jnp.mean(jnp.square(tf), axis=-1, keepdims=True) + NORM_EPS) * g).astype(t.dtype)


def _partial_rope(t):
    L = t.shape[1]
    inv = ROPE_THETA ** (-jnp.arange(0, ROT_DIM, 2, dtype=jnp.float32) / ROT_DIM)
    ang = jnp.arange(L, dtype=jnp.float32)[:, None] * inv[None, :]
    cos = jnp.cos(ang)[None, :, None, :]
    sin = jnp.sin(ang)[None, :, None, :]
    tr = t[..., :ROT_DIM].astype(jnp.float32)
    t1, t2 = tr[..., :ROT_DIM // 2], tr[..., ROT_DIM // 2:]
    rot = jnp.concatenate([t1 * cos - t2 * sin, t2 * cos + t1 * sin], axis=-1)
    return jnp.concatenate([rot.astype(t.dtype), t[..., ROT_DIM:]], axis=-1)


def _window_gqa(q, k, v, sink):
    B, L = q.shape[0], q.shape[1]
    nb = L // BLOCK
    qb = q.reshape(B, nb, BLOCK, N_KV_HEADS, GQA_GROUPS, HEAD_DIM)

    def neighbours(t):
        tp = jnp.pad(t, ((0, 0), (BLOCK, BLOCK), (0, 0), (0, 0)))
        return jnp.concatenate(
            [tp[:, i * BLOCK:i * BLOCK + L].reshape(B, nb, BLOCK, N_KV_HEADS, HEAD_DIM) for i in range(3)],
            axis=2)

    kb, vb = neighbours(k), neighbours(v)
    s = jnp.einsum('bnqkgd,bnskd->bnkgqs', qb, kb).astype(jnp.float32) * (HEAD_DIM ** -0.5)
    blk = jnp.arange(nb)[:, None, None]
    qpos = blk * BLOCK + jnp.arange(BLOCK)[None, :, None]
    kpos = (blk - 1) * BLOCK + jnp.arange(3 * BLOCK)[None, None, :]
    valid = (jnp.abs(kpos - qpos) <= WINDOW) & (kpos >= 0) & (kpos < L)
    s = jnp.where(valid[None, :, None, None], s, MASK_VALUE)
    sk = sink.astype(jnp.float32).reshape(N_KV_HEADS, GQA_GROUPS)[:, :, None, None]
    m = jnp.maximum(jnp.max(s, axis=-1, keepdims=True), sk)
    p = jnp.exp(s - m)
    p = p / (jnp.sum(p, axis=-1, keepdims=True) + jnp.exp(sk - m))
    o = jnp.einsum('bnkgqs,bnskd->bnqkgd', p.astype(v.dtype), vb)
    return o.reshape(B, L, N_HEADS * HEAD_DIM)


def _short_conv(u, w, b):
    up = jnp.pad(u, ((0, 0), (1, 1), (0, 0)))
    return up[:, :-2] * w[0] + up[:, 1:-1] * w[1] + up[:, 2:] * w[2] + b


def _hyena_filters(L, w1, b1, f1, w2, b2, f2, w3, decay):
    pos = jnp.arange(L, dtype=jnp.float32)
    t = pos / (L - 1)
    w = 2.0 * math.pi * pos / L
    bands = jnp.linspace(1e-4, FILTER_BANDS - 1, FILTER_BANDS, dtype=jnp.float32)
    ang = w[:, None] * bands[None, :]
    z = jnp.concatenate([t[:, None], jnp.cos(ang), -jnp.sin(ang)], axis=-1)
    h = jnp.sin(f1 * (z @ w1 + b1))
    h = jnp.sin(f2 * (h @ w2 + b2))
    h = (h @ w3).astype(jnp.float32)
    h = h * jnp.exp(-t[:, None] * jnp.abs(decay.astype(jnp.float32))[None, :])
    h = h.reshape(L, HYENA_ORDER, 2, D_HYENA)
    h = h / jnp.sum(jnp.abs(h), axis=(0, 2), keepdims=True)
    fwd, bwd = h[:, :, 0], h[:, :, 1]
    full = jnp.concatenate([fwd, jnp.zeros((1, HYENA_ORDER, D_HYENA), jnp.float32), bwd[:0:-1]], axis=0)
    return jnp.fft.rfft(full, axis=0)


def _fftconv(u, kf, d):
    L = u.shape[1]
    uf = u.astype(jnp.float32)
    y = jnp.fft.irfft(jnp.fft.rfft(uf, n=2 * L, axis=1) * kf[None], n=2 * L, axis=1)[:, :L]
    return (y + uf * d.astype(jnp.float32)).astype(u.dtype)


def _layer(x, w_in, sink, conv_w, conv_b, fw1, fb1, ff1, fw2, fb2, ff2, fw3, fdecay,
           hy_d, attn_g, hy_g, w_out, ln_g, ln_b):
    B, L, _ = x.shape
    proj = jnp.einsum('bld,de->ble', x, w_in)
    q, k, v, g_a, hy, g_h = jnp.split(proj, SPLIT_POINTS, axis=-1)
    q = _partial_rope(q.reshape(B, L, N_HEADS, HEAD_DIM))
    k = _partial_rope(k.reshape(B, L, N_KV_HEADS, HEAD_DIM))
    v = v.reshape(B, L, N_KV_HEADS, HEAD_DIM)
    a = _window_gqa(q, k, v, sink)
    hv, hx1, hx2 = jnp.split(_short_conv(hy, conv_w, conv_b), 3, axis=-1)
    kf = _hyena_filters(L, fw1, fb1, ff1, fw2, fb2, ff2, fw3, fdecay)
    z = hv
    for n, gate in enumerate((hx1, hx2)):
        z = gate * _fftconv(z, kf[:, n], hy_d[n])
    a = _rmsnorm(a, attn_g) * jax.nn.silu(g_a)
    z = _rmsnorm(z, hy_g) * jax.nn.silu(g_h)
    out = jnp.einsum('ble,ed->bld', jnp.concatenate([a, z], axis=-1), w_out)
    return _layernorm(DN_ALPHA * x + out, ln_g, ln_b)


def setup_inputs(seed: int = 0) -> dict:
    key = jax.random.key(seed)
    ks = jax.random.split(key, 24)
    f32 = jnp.float32

    def nrm(k, shape, s):
        return s * jax.random.normal(k, shape, f32)

    col_scale = (jnp.ones((D_IN,), f32)
                 .at[V_START:V_START + KV_COLS].set(DN_BETA)
                 .at[HYV_START:HYV_START + D_HYENA].set(DN_BETA))
    decay_base = jnp.tile(jnp.linspace(DECAY_SLOW, DECAY_FAST, D_HYENA, dtype=f32), HYENA_ORDER * 2)
    return {
        'x_prompt': nrm(ks[0], (BATCH, SEQ, D_MODEL), 1.0),
        'x_sample': nrm(ks[1], (DEC_BATCH, DEC_SEQ, D_MODEL), 1.0),
        'emb_ln_g': 1.0 + nrm(ks[2], (D_MODEL,), 0.02),
        'emb_ln_b': nrm(ks[3], (D_MODEL,), 0.02),
        'w_in': nrm(ks[4], (DEPTH, D_MODEL, D_IN), D_MODEL ** -0.5) * col_scale,
        'attn_sink': nrm(ks[5], (DEPTH, N_HEADS), 0.5),
        'conv_w': nrm(ks[6], (DEPTH, 3, 3 * D_HYENA), 3 ** -0.5),
        'conv_b': nrm(ks[7], (DEPTH, 3 * D_HYENA), 0.02),
        'flt_w1': nrm(ks[8], (DEPTH, FILTER_EMB, FILTER_HIDDEN), FILTER_EMB ** -0.5),
        'flt_b1': nrm(ks[9], (DEPTH, FILTER_HIDDEN), 0.02),
        'flt_freq1': 1.0 + nrm(ks[10], (DEPTH, FILTER_HIDDEN), 0.1),
        'flt_w2': nrm(ks[11], (DEPTH, FILTER_HIDDEN, FILTER_HIDDEN), FILTER_HIDDEN ** -0.5),
        'flt_b2': nrm(ks[12], (DEPTH, FILTER_HIDDEN), 0.02),
        'flt_freq2': 1.0 + nrm(ks[13], (DEPTH, FILTER_HIDDEN), 0.1),
        'flt_w3': nrm(ks[14], (DEPTH, FILTER_HIDDEN, N_FILTERS), FILTER_HIDDEN ** -0.5),
        'flt_decay': decay_base * (1.0 + nrm(ks[15], (DEPTH, N_FILTERS), 0.05)),
        'hyena_d': nrm(ks[16], (DEPTH, HYENA_ORDER, D_HYENA), 0.5),
        'attn_norm_g': 1.0 + nrm(ks[17], (DEPTH, D_ATTN), 0.02),
        'hyena_norm_g': 1.0 + nrm(ks[18], (DEPTH, D_HYENA), 0.02),
        'w_out': nrm(ks[19], (DEPTH, D_MIX, D_MODEL), D_MIX ** -0.5 * DN_BETA),
        'ln_g': 1.0 + nrm(ks[20], (DEPTH, D_MODEL), 0.02),
        'ln_b': nrm(ks[21], (DEPTH, D_MODEL), 0.02),
    }


def reference(x_prompt, x_sample, emb_ln_g, emb_ln_b, w_in, attn_sink, conv_w, conv_b,
              flt_w1, flt_b1, flt_freq1, flt_w2, flt_b2, flt_freq2, flt_w3, flt_decay,
              hyena_d, attn_norm_g, hyena_norm_g, w_out, ln_g, ln_b):
    def trunk(x):
        h = _layernorm(x, emb_ln_g, emb_ln_b)
        for l in range(DEPTH):
            h = _layer(h, w_in[l], attn_sink[l], conv_w[l], conv_b[l],
                       flt_w1[l], flt_b1[l], flt_freq1[l], flt_w2[l], flt_b2[l], flt_freq2[l],
                       flt_w3[l], flt_decay[l], hyena_d[l], attn_norm_g[l], hyena_norm_g[l],
                       w_out[l], ln_g[l], ln_b[l])
        return h

    y_prompt = trunk(x_prompt)
    y_sample = trunk(x_sample)
    return (y_prompt, y_sample)
```

```cpp
#include <hip/hip_runtime.h>
#include <cstdio>
#include <cstdint>
namespace pg8 {
#define PG8_LAS __attribute__((address_space(3)))
typedef unsigned short bf16_t;
typedef short bf16x8 __attribute__((ext_vector_type(8)));
typedef float f32x4 __attribute__((ext_vector_type(4)));
typedef unsigned u32x4 __attribute__((ext_vector_type(4)));
constexpr int BM = 256, BK = 64, HALF = 128, HTB = HALF * BK * 2  , STAGE_BYTES = 8 * HTB, NXCD = 8, WGM = 8;

__host__ __device__ __forceinline__ int lds_byte(int r, int c) { const int st = (r >> 4) * 2 + (c >> 5), rr = r & 15, cc = c & 31, ob = rr * 64 + cc * 2; return st * 1024 + (ob ^ (((ob >> 9) & 1) << 5)); }
__host__ __device__ __forceinline__ void stage_rc(int b, int& R, int& C) { const int st = b / 1024, sb = b % 1024, swz = sb ^ (((sb >> 9) & 1) << 5); R = (st >> 1) * 16 + swz / 64; C = (st & 1) * 32 + (swz % 64) / 2; }
__host__ __device__ __forceinline__ int perm32(int rho) { const int n = rho >> 4, i = rho & 15; return 8 * (i >> 2) + 4 * n + (i & 3); }

struct Unit { int pm, pn; };
struct Gemm { const bf16_t* A; const bf16_t* Bt; int M, N, K; };

struct StaticOrder {
    int nM, nN, nwg, G, c;
    __host__ __device__ void init(int M, int N, int G_, int c_) { nM = M / BM; nN = N / BM; nwg = nM * nN; G = G_; c = c_; }
    __host__ __device__ bool next(int i, Unit& u) const {
        const long L = (long)i * G + c; if (L >= nwg) return false;
        int wgid = (int)L; { const int q = nwg / NXCD, r = nwg % NXCD, xcd = wgid % NXCD, off = wgid / NXCD; wgid = (xcd < r ? xcd * (q + 1) : r * (q + 1) + (xcd - r) * q) + off; }
        const int nig = WGM * nN, gid = wgid / nig, fm = gid * WGM, gsz = (nM - fm) < WGM ? (nM - fm) : WGM;
        u.pm = fm + ((wgid % nig) % gsz); u.pn = (wgid % nig) / gsz; return true;
    }
    __device__ __forceinline__ void a_ready(const Unit&) const {}
    __device__ __forceinline__ void done(const Unit&) const {}
};

__device__ __forceinline__ unsigned cvt_pk_bf16(float lo, float hi) { unsigned r; asm volatile("v_cvt_pk_bf16_f32 %0, %1, %2" : "=v"(r) : "v"(lo), "v"(hi)); return r; }
typedef float f32x2 __attribute__((ext_vector_type(2)));
__device__ __forceinline__ f32x2 gelu_pk(f32x2 v) {
    const f32x2 av = __builtin_elementwise_abs(v), d = av * 0.2316418882f + 1.0f;
    f32x2 t; t.x = __builtin_amdgcn_rcpf(d.x); t.y = __builtin_amdgcn_rcpf(d.y);
    f32x2 q = t * 0.5307027145f + (-0.7265760135f); q = q * t + 0.7107068705f; q = q * t + (-0.142248368f); q = q * t + 0.127414796f; q = q * t;
    const f32x2 s = (v * v) * (-0.72134752044f);
    f32x2 e; e.x = __builtin_amdgcn_exp2f(s.x); e.y = __builtin_amdgcn_exp2f(s.y);
    const f32x2 m = v * (q * e), r = v - m;
    f32x2 o; o.x = v.x < 0.f ? m.x : r.x; o.y = v.y < 0.f ? m.y : r.y; return o;
}

template <int ACT  > struct EpiBf16 {
    static constexpr bool PERM = true, AFTER_DRAIN = false; static_assert(ACT == 0 || ACT == 1, "EpiBf16: ACT is 0 (none) or 1 (gelu_pk)");
    bf16_t* O; int ldc; const float* bias; int split_cols; size_t split_stride; float scale0;
    __device__ __forceinline__ void operator()(const f32x4 (&acc)[2][2][4][2], const Unit& u, int wr, int wc, int fr, int fq) const {
        const int row0 = u.pm * BM + wr * 64 + fr; int colt = u.pn * BM; bf16_t* base = O;
        float sc = 1.f; if (split_cols) { const int t = colt / split_cols; base += (size_t)t * split_stride; colt -= t * split_cols; if (t == 0) sc = scale0; }
        const int col0 = colt + wc * 32 + 8 * fq, bcol0 = u.pn * BM + wc * 32 + 8 * fq;
        f32x4 bv[2][2];
#pragma unroll
        for (int bj = 0; bj < 2; ++bj)
#pragma unroll
            for (int n = 0; n < 2; ++n) bv[bj][n] = bias ? *(const f32x4*)(bias + bcol0 + bj * HALF + 4 * n) : (f32x4){0.f, 0.f, 0.f, 0.f};
#pragma unroll
        for (int ai = 0; ai < 2; ++ai)
#pragma unroll
            for (int m = 0; m < 4; ++m) { bf16_t* rowp = base + (size_t)(row0 + ai * HALF + m * 16) * ldc + col0;
#pragma unroll
                for (int bj = 0; bj < 2; ++bj) { f32x4 v0 = acc[ai][bj][m][0] + bv[bj][0], v1 = acc[ai][bj][m][1] + bv[bj][1];
                    if (ACT == 1) { f32x2 a = gelu_pk((f32x2){v0[0], v0[1]}), b = gelu_pk((f32x2){v0[2], v0[3]}), c = gelu_pk((f32x2){v1[0], v1[1]}), d = gelu_pk((f32x2){v1[2], v1[3]});
                        v0 = (f32x4){a.x, a.y, b.x, b.y}; v1 = (f32x4){c.x, c.y, d.x, d.y}; }
                    v0 = v0 * sc; v1 = v1 * sc; u32x4 w; w.x = cvt_pk_bf16(v0[0], v0[1]); w.y = cvt_pk_bf16(v0[2], v0[3]); w.z = cvt_pk_bf16(v1[0], v1[1]); w.w = cvt_pk_bf16(v1[2], v1[3]);
                    *(u32x4*)(rowp + bj * HALF) = w; } }
    }
};

constexpr int MTOK = 24576, LP = 8192, LS = 2048, DMOD = 2048, DIN = 6656;
constexpr int QKVG_W = 2560;
constexpr float DN_ALPHA_F = 1.41421356237f;

__device__ __forceinline__ float silu_f(float x) { return x / (1.0f + __expf(-x)); }

struct EpiIn {
    static constexpr bool PERM = true, AFTER_DRAIN = false;
    bf16_t* qkvg; bf16_t* gh; bf16_t* hyt;
    __device__ __forceinline__ void operator()(const f32x4 (&acc)[2][2][4][2], const Unit& u, int wr, int wc, int fr, int fq) const {
        const int row0 = u.pm * BM + wr * 64 + fr; const int colt = u.pn * BM;
#pragma unroll
        for (int ai = 0; ai < 2; ++ai)
#pragma unroll
            for (int m = 0; m < 4; ++m) { const int row = row0 + ai * HALF + m * 16;
#pragma unroll
                for (int bj = 0; bj < 2; ++bj) { f32x4 v0 = acc[ai][bj][m][0], v1 = acc[ai][bj][m][1];
                    const int c0 = colt + bj * HALF + wc * 32 + 8 * fq;
                    if (colt < 2560) {
                        if (colt >= 1536) { for (int e = 0; e < 4; ++e) { v0[e] = silu_f(v0[e]); v1[e] = silu_f(v1[e]); } }
                        u32x4 w; w.x = cvt_pk_bf16(v0[0], v0[1]); w.y = cvt_pk_bf16(v0[2], v0[3]); w.z = cvt_pk_bf16(v1[0], v1[1]); w.w = cvt_pk_bf16(v1[2], v1[3]);
                        *(u32x4*)(qkvg + (size_t)row * QKVG_W + c0) = w;
                    } else if (colt < 5632) {
                        u32x4 w; w.x = cvt_pk_bf16(v0[0], v0[1]); w.y = cvt_pk_bf16(v0[2], v0[3]); w.z = cvt_pk_bf16(v1[0], v1[1]); w.w = cvt_pk_bf16(v1[2], v1[3]);
                        const int ch = c0 - 2560;
                        bf16_t* p = hyt + (size_t)ch * MTOK + row;
                        p[0] = (bf16_t)(w.x & 0xffff); p[(size_t)MTOK] = (bf16_t)(w.x >> 16); p[(size_t)2 * MTOK] = (bf16_t)(w.y & 0xffff); p[(size_t)3 * MTOK] = (bf16_t)(w.y >> 16);
                        p[(size_t)4 * MTOK] = (bf16_t)(w.z & 0xffff); p[(size_t)5 * MTOK] = (bf16_t)(w.z >> 16); p[(size_t)6 * MTOK] = (bf16_t)(w.w & 0xffff); p[(size_t)7 * MTOK] = (bf16_t)(w.w >> 16);
                    } else {
                        for (int e = 0; e < 4; ++e) { v0[e] = silu_f(v0[e]); v1[e] = silu_f(v1[e]); }
                        u32x4 w; w.x = cvt_pk_bf16(v0[0], v0[1]); w.y = cvt_pk_bf16(v0[2], v0[3]); w.z = cvt_pk_bf16(v1[0], v1[1]); w.w = cvt_pk_bf16(v1[2], v1[3]);
                        *(u32x4*)(gh + (size_t)row * 1024 + (c0 - 5632)) = w;
                    } } }
    }
};
struct EpiOut {
    static constexpr bool PERM = true, AFTER_DRAIN = false;
    float* dout;
    __device__ __forceinline__ void operator()(const f32x4 (&acc)[2][2][4][2], const Unit& u, int wr, int wc, int fr, int fq) const {
        const int row0 = u.pm * BM + wr * 64 + fr; const int colt = u.pn * BM;
#pragma unroll
        for (int ai = 0; ai < 2; ++ai)
#pragma unroll
            for (int m = 0; m < 4; ++m) { const int row = row0 + ai * HALF + m * 16;
#pragma unroll
                for (int bj = 0; bj < 2; ++bj) { const int c0 = colt + bj * HALF + wc * 32 + 8 * fq;
                    float* p = dout + (size_t)row * DMOD + c0;
                    f32x4 r0 = *(const f32x4*)p, r1 = *(const f32x4*)(p + 4);
                    r0 = r0 * DN_ALPHA_F + acc[ai][bj][m][0]; r1 = r1 * DN_ALPHA_F + acc[ai][bj][m][1];
                    *(f32x4*)p = r0; *(f32x4*)(p + 4) = r1; } }
    }
};
template <class Epi, class Sched, bool ALIGN_EPI = false, bool SP2 = false>
__device__ __forceinline__ void gemm_phase(PG8_LAS unsigned char* lds, const Gemm g, const Sched& S, const Epi& E) {
    const int tid = threadIdx.x, wid = __builtin_amdgcn_readfirstlane(tid >> 6), lane = tid & 63, wr = wid >> 2, wc = wid & 3, fr = lane & 15, fq = lane >> 4;
    const int K = g.K, nt = K / BK;
    unsigned voffA[2], voffB[2];
#pragma unroll
    for (int i = 0; i < 2; ++i) { int R, C; stage_rc(tid * 16 + i * 8192, R, C); const int Rb = Epi::PERM ? ((R & ~31) + perm32(R & 31)) : R;
        voffA[i] = (unsigned)(R * K + C) * 2u; voffB[i] = (unsigned)(Rb * K + C) * 2u; }
    const size_t kstep = (size_t)(BK * 2);
    const size_t hstep = (size_t)HALF * K * 2;
    const size_t tstep = 2 * hstep;
    const unsigned ldsw = (unsigned)wid * 1024u;
    const int aoff = lds_byte(wr * 64 + fr, fq * 8), boff = lds_byte(wc * 32 + fr, fq * 8);
#define PG8_SA(b, h) (((b) * 2 + (h)) * HTB)
#define PG8_SB(b, h) ((4 + (b) * 2 + (h)) * HTB)
#define PG8_STAGE(bufoff, gbase, voff) do { _Pragma("unroll") for (int _i = 0; _i < 2; ++_i) \
        __builtin_amdgcn_global_load_lds((const unsigned*)((const char*)(gbase) + (voff)[_i]), (PG8_LAS unsigned*)(lds + (bufoff) + ldsw + _i * 8192), 16, 0, 0); } while (0)
#define PG8_LDA(dst, b, h) do { _Pragma("unroll") for (int m = 0; m < 4; ++m) _Pragma("unroll") for (int k = 0; k < 2; ++k) dst[m][k] = *(const PG8_LAS bf16x8*)(lds + PG8_SA(b, h) + aoff + m * 2048 + k * 1024); } while (0)
#define PG8_LDB(dst, b, h) do { _Pragma("unroll") for (int n = 0; n < 2; ++n) _Pragma("unroll") for (int k = 0; k < 2; ++k) dst[n][k] = *(const PG8_LAS bf16x8*)(lds + PG8_SB(b, h) + boff + n * 2048 + k * 1024); } while (0)
#define PG8_MMA(ai, bj, At, Bt) do { __builtin_amdgcn_s_setprio(1); _Pragma("unroll") for (int m = 0; m < 4; ++m) _Pragma("unroll") for (int n = 0; n < 2; ++n) _Pragma("unroll") for (int k = 0; k < 2; ++k) \
        acc[ai][bj][m][n] = __builtin_amdgcn_mfma_f32_16x16x32_bf16(Bt[n][k], At[m][k], acc[ai][bj][m][n], 0, 0, 0); __builtin_amdgcn_s_setprio(0); } while (0)
#define PG8_WAIT_V(n) asm volatile("s_waitcnt vmcnt(" #n ")" ::: "memory")
#define PG8_WAIT_L(n) asm volatile("s_waitcnt lgkmcnt(" #n ")" ::: "memory")
#define PG8_BAR __builtin_amdgcn_s_barrier()
#define PG8_SCHED __builtin_amdgcn_sched_barrier(0)
    Unit cur, nxt; int ui = 0;
    if (!S.next(0, cur)) return;
    f32x4 acc[2][2][4][2];
#pragma unroll
    for (int a = 0; a < 2; ++a)
#pragma unroll
        for (int b = 0; b < 2; ++b)
#pragma unroll
            for (int m = 0; m < 4; ++m)
#pragma unroll
                for (int n = 0; n < 2; ++n) acc[a][b][m][n] = (f32x4){0.f, 0.f, 0.f, 0.f};
    bf16x8 At[4][2], B0[2][2], B1[2][2];
    const char* cA = (const char*)g.A + (size_t)cur.pm * tstep; const char* cB = (const char*)g.Bt + (size_t)cur.pn * tstep;
    S.a_ready(cur);
    if constexpr (SP2) {
        PG8_STAGE(PG8_SB(0, 0), cB, voffB); PG8_STAGE(PG8_SB(0, 1), cB + hstep, voffB); PG8_STAGE(PG8_SA(0, 0), cA, voffA); PG8_STAGE(PG8_SA(0, 1), cA + hstep, voffA);
        if (wr == 1) PG8_BAR;
        PG8_WAIT_V(2); PG8_BAR;
        PG8_STAGE(PG8_SB(1, 0), cB + kstep, voffB); PG8_STAGE(PG8_SA(1, 0), cA + kstep, voffA); PG8_STAGE(PG8_SB(1, 1), cB + hstep + kstep, voffB);
        PG8_WAIT_V(6); PG8_BAR;
    } else {
        PG8_STAGE(PG8_SB(0, 0), cB, voffB); PG8_STAGE(PG8_SA(0, 0), cA, voffA); PG8_STAGE(PG8_SB(0, 1), cB + hstep, voffB); PG8_STAGE(PG8_SA(0, 1), cA + hstep, voffA);
        if (wr == 1) PG8_BAR;
        PG8_WAIT_V(4); PG8_BAR;
        PG8_STAGE(PG8_SB(1, 0), cB + kstep, voffB); PG8_STAGE(PG8_SA(1, 0), cA + kstep, voffA); PG8_STAGE(PG8_SB(1, 1), cB + hstep + kstep, voffB);
        PG8_WAIT_V(6); PG8_BAR;
    }
    for (;;) {
        const bool has_next = S.next(ui + 1, nxt);
        const char* nA = has_next ? (const char*)g.A + (size_t)nxt.pm * tstep : cA; const char* nB = has_next ? (const char*)g.Bt + (size_t)nxt.pn * tstep : cB;
        for (int t = 0; t < nt; t += 2) {
            const bool last = (t == nt - 2);
            const char* a1 = cA + (size_t)(t + 1) * kstep;
            const char* a2 = last ? nA : cA + (size_t)(t + 2) * kstep; const char* b2 = last ? nB : cB + (size_t)(t + 2) * kstep;
            const char* a3 = a2 + kstep; const char* b3 = b2 + kstep;
            if (last && has_next) S.a_ready(nxt);
            if constexpr (SP2) {
            PG8_LDB(B0, 0, 0); PG8_LDB(B1, 0, 1); PG8_SCHED; PG8_LDA(At, 0, 0); PG8_STAGE(PG8_SA(1, 1), a1 + hstep, voffA);
            PG8_WAIT_V(8); PG8_WAIT_L(0); PG8_BAR; PG8_MMA(0, 0, At, B0); PG8_MMA(0, 1, At, B1); PG8_BAR; PG8_SCHED;
            PG8_LDA(At, 0, 1); PG8_STAGE(PG8_SB(0, 0), b2, voffB); PG8_STAGE(PG8_SB(0, 1), b2 + hstep, voffB); PG8_STAGE(PG8_SA(0, 0), a2, voffA);
            PG8_WAIT_V(8); PG8_WAIT_L(0); PG8_BAR; PG8_MMA(1, 0, At, B0); PG8_MMA(1, 1, At, B1); PG8_BAR; PG8_SCHED;
            PG8_LDB(B0, 1, 0); PG8_LDB(B1, 1, 1); PG8_SCHED; PG8_LDA(At, 1, 0); PG8_STAGE(PG8_SA(0, 1), a2 + hstep, voffA);
            PG8_WAIT_V(8); PG8_WAIT_L(0); PG8_BAR; PG8_MMA(0, 0, At, B0); PG8_MMA(0, 1, At, B1); PG8_BAR; PG8_SCHED;
            PG8_LDA(At, 1, 1); PG8_STAGE(PG8_SB(1, 0), b3, voffB); PG8_STAGE(PG8_SB(1, 1), b3 + hstep, voffB); PG8_STAGE(PG8_SA(1, 0), a3, voffA);
            PG8_WAIT_V(8); PG8_WAIT_L(0); PG8_BAR; PG8_MMA(1, 0, At, B0); PG8_MMA(1, 1, At, B1); PG8_BAR; PG8_SCHED;
            } else {
            PG8_LDB(B0, 0, 0); PG8_SCHED; PG8_LDA(At, 0, 0); PG8_STAGE(PG8_SA(1, 1), a1 + hstep, voffA);
            PG8_WAIT_L(8); PG8_BAR; PG8_WAIT_L(0); PG8_MMA(0, 0, At, B0); PG8_BAR; PG8_SCHED;
            PG8_LDB(B1, 0, 1); PG8_STAGE(PG8_SB(0, 0), b2, voffB);
            PG8_BAR; PG8_WAIT_L(0); PG8_MMA(0, 1, At, B1); PG8_BAR;
            PG8_LDA(At, 0, 1); PG8_STAGE(PG8_SA(0, 0), a2, voffA);
            PG8_BAR; PG8_WAIT_L(0); PG8_MMA(1, 0, At, B0); PG8_BAR; PG8_SCHED;
            PG8_STAGE(PG8_SB(0, 1), b2 + hstep, voffB);
            PG8_WAIT_V(6); PG8_BAR; PG8_MMA(1, 1, At, B1); PG8_BAR;
            PG8_LDB(B0, 1, 0); PG8_SCHED; PG8_LDA(At, 1, 0); PG8_STAGE(PG8_SA(0, 1), a2 + hstep, voffA);
            PG8_WAIT_L(8); PG8_BAR; PG8_WAIT_L(0); PG8_MMA(0, 0, At, B0); PG8_BAR; PG8_SCHED;
            PG8_LDB(B1, 1, 1); PG8_STAGE(PG8_SB(1, 0), b3, voffB);
            PG8_BAR; PG8_WAIT_L(0); PG8_MMA(0, 1, At, B1); PG8_BAR;
            PG8_LDA(At, 1, 1); PG8_STAGE(PG8_SA(1, 0), a3, voffA);
            PG8_BAR; PG8_WAIT_L(0); PG8_MMA(1, 0, At, B0); PG8_BAR; PG8_SCHED;
            PG8_STAGE(PG8_SB(1, 1), b3 + hstep, voffB);
            PG8_WAIT_V(6); PG8_BAR; PG8_MMA(1, 1, At, B1); PG8_BAR;
            }
        }
        if constexpr (ALIGN_EPI) { if (wr == 0) PG8_BAR; }
        if constexpr (!Epi::AFTER_DRAIN) { E(acc, cur, wr, wc, fr, fq); S.done(cur); }
        if (!has_next) break;
#pragma unroll
        for (int a = 0; a < 2; ++a)
#pragma unroll
            for (int b = 0; b < 2; ++b)
#pragma unroll
                for (int m = 0; m < 4; ++m)
#pragma unroll
                    for (int n = 0; n < 2; ++n) acc[a][b][m][n] = (f32x4){0.f, 0.f, 0.f, 0.f};
        cur = nxt; cA = nA; cB = nB; ++ui;
        if constexpr (ALIGN_EPI) { if (wr == 1) PG8_BAR; }
    }
    PG8_WAIT_V(0);
    if constexpr (!ALIGN_EPI) { if (wr == 0) PG8_BAR; }
    PG8_BAR;
    if constexpr (Epi::AFTER_DRAIN) { E.fused(acc, cur, wr, wc, fr, fq, lds, wid, lane); S.done(cur); }
#undef PG8_SA
#undef PG8_SB
#undef PG8_STAGE
#undef PG8_LDA
#undef PG8_LDB
#undef PG8_MMA
#undef PG8_WAIT_V
#undef PG8_WAIT_L
#undef PG8_BAR
#undef PG8_SCHED
}
}

using pg8::bf16_t; using pg8::MTOK; using pg8::LP; using pg8::LS; using pg8::DMOD; using pg8::DIN; using pg8::QKVG_W;
typedef unsigned u32x4_t __attribute__((ext_vector_type(4)));
typedef float f32x4_t __attribute__((ext_vector_type(4)));

__device__ __forceinline__ float bf2f(unsigned short b) { return __uint_as_float(((unsigned)b) << 16); }
__device__ __forceinline__ unsigned short f2bf(float f) { unsigned u = __float_as_uint(f); return (unsigned short)((u + 0x7fffu + ((u >> 16) & 1u)) >> 16); }

__global__ void __launch_bounds__(512, 2) gemm_in_kernel(const bf16_t* A, const bf16_t* Bt, bf16_t* qkvg, bf16_t* gh, bf16_t* hyt) {
    extern __shared__ __attribute__((aligned(16))) unsigned char lds[];
    pg8::Gemm g{A, Bt, MTOK, DIN, DMOD}; pg8::StaticOrder S; S.init(MTOK, DIN, gridDim.x, (int)blockIdx.x);
    pg8::EpiIn E{qkvg, gh, hyt};
    pg8::gemm_phase<pg8::EpiIn, pg8::StaticOrder, true, true>((PG8_LAS unsigned char*)lds, g, S, E);
}
__global__ void __launch_bounds__(512, 2) gemm_out_kernel(const bf16_t* A, const bf16_t* Bt, float* dout) {
    extern __shared__ __attribute__((aligned(16))) unsigned char lds[];
    pg8::Gemm g{A, Bt, MTOK, DMOD, DMOD}; pg8::StaticOrder S; S.init(MTOK, DMOD, gridDim.x, (int)blockIdx.x);
    pg8::EpiOut E{dout};
    pg8::gemm_phase<pg8::EpiOut, pg8::StaticOrder, true, true>((PG8_LAS unsigned char*)lds, g, S, E);
}

__global__ void transpose_w_kernel(const float* W, bf16_t* WT, int K, int N) {
    __shared__ float t[32][33];
    const int n0 = blockIdx.x * 32, k0 = blockIdx.y * 32, tx = threadIdx.x & 31, ty = threadIdx.x >> 5;
    for (int i = 0; i < 4; ++i) t[ty + 8 * i][tx] = W[(size_t)(k0 + ty + 8 * i) * N + n0 + tx];
    __syncthreads();
    for (int i = 0; i < 4; ++i) WT[(size_t)(n0 + ty + 8 * i) * K + k0 + tx] = f2bf(t[tx][ty + 8 * i]);
}
__global__ void ln_rows_kernel(const float* in0, const float* in1, int split, const float* g, const float* b, float* outf, bf16_t* outb) {
    const int m = blockIdx.x, tid = threadIdx.x;
    const float* src = (m < split) ? in0 + (size_t)m * DMOD : in1 + (size_t)(m - split) * DMOD;
    f32x4_t v0 = *(const f32x4_t*)(src + tid * 8), v1 = *(const f32x4_t*)(src + tid * 8 + 4);
    __shared__ float red[8];
    float s = (v0[0] + v0[1]) + (v0[2] + v0[3]) + (v1[0] + v1[1]) + (v1[2] + v1[3]);
    for (int o = 1; o < 64; o <<= 1) s += __shfl_xor(s, o);
    if ((tid & 63) == 0) red[tid >> 6] = s;
    __syncthreads();
    const float mean = (red[0] + red[1] + red[2] + red[3]) * (1.0f / DMOD);
    v0 = v0 - mean; v1 = v1 - mean;
    float q = (v0[0] * v0[0] + v0[1] * v0[1]) + (v0[2] * v0[2] + v0[3] * v0[3]) + (v1[0] * v1[0] + v1[1] * v1[1]) + (v1[2] * v1[2] + v1[3] * v1[3]);
    for (int o = 1; o < 64; o <<= 1) q += __shfl_xor(q, o);
    if ((tid & 63) == 0) red[4 + (tid >> 6)] = q;
    __syncthreads();
    const float rstd = rsqrtf((red[4] + red[5] + red[6] + red[7]) * (1.0f / DMOD) + 1e-5f);
    const f32x4_t g0 = *(const f32x4_t*)(g + tid * 8), g1 = *(const f32x4_t*)(g + tid * 8 + 4), b0 = *(const f32x4_t*)(b + tid * 8), b1 = *(const f32x4_t*)(b + tid * 8 + 4);
    v0 = v0 * rstd * g0 + b0; v1 = v1 * rstd * g1 + b1;
    *(f32x4_t*)(outf + (size_t)m * DMOD + tid * 8) = v0; *(f32x4_t*)(outf + (size_t)m * DMOD + tid * 8 + 4) = v1;
    u32x4_t w; w.x = f2bf(v0[0]) | ((unsigned)f2bf(v0[1]) << 16); w.y = f2bf(v0[2]) | ((unsigned)f2bf(v0[3]) << 16); w.z = f2bf(v1[0]) | ((unsigned)f2bf(v1[1]) << 16); w.w = f2bf(v1[2]) | ((unsigned)f2bf(v1[3]) << 16);
    *(u32x4_t*)(outb + (size_t)m * DMOD + tid * 8) = w;
}
__device__ __forceinline__ void seq_of_row(int m, int& start, int& L, int& pos) {
    if (m < LP) { start = 0; L = LP; pos = m; } else { const int r = m - LP; start = LP + (r / LS) * LS; L = LS; pos = r % LS; }
}
__global__ void rope_kernel(bf16_t* qkvg) {
    const int idx = blockIdx.x * 256 + threadIdx.x; const int i = idx & 7, hh = (idx >> 3) % 20, m = idx / 160;
    if (m >= MTOK) return;
    int st, L, pos; seq_of_row(m, st, L, pos);
    const int col = (hh < 16 ? hh * 64 : 1024 + (hh - 16) * 64) + i;
    const float inv = powf(500000.0f, -(float)(2 * i) / 16.0f);
    const float ang = (float)pos * inv; const float c = cosf(ang), s = sinf(ang);
    bf16_t* p = qkvg + (size_t)m * QKVG_W + col;
    const float t1 = bf2f(p[0]), t2 = bf2f(p[8]);
    p[0] = f2bf(t1 * c - t2 * s); p[8] = f2bf(t2 * c + t1 * s);
}
__global__ void __launch_bounds__(128) attn_naive_kernel(bf16_t* qkvg, const float* sink) {
    __shared__ float Ks[64][64]; __shared__ float Vs[64][64];
    const int qb = blockIdx.x, h = blockIdx.y, tid = threadIdx.x, kv = h >> 2;
    const int m = qb * 128 + tid; int st, L, pos; seq_of_row(m, st, L, pos);
    const int pos0 = pos - tid;
    float q[64], o[64];
    { const bf16_t* qp = qkvg + (size_t)m * QKVG_W + h * 64;
#pragma unroll
      for (int d = 0; d < 64; ++d) { q[d] = bf2f(qp[d]) * 0.125f; o[d] = 0.f; } }
    float mx = sink[h], l = 1.0f;
    const int klo = max(0, pos0 - 128), khi = min(L, pos0 + 256);
    for (int k0 = klo; k0 < khi; k0 += 64) {
        __syncthreads();
        for (int e = tid; e < 64 * 64; e += 128) { const int j = e >> 6, d = e & 63; const size_t r = (size_t)(st + k0 + j) * QKVG_W;
            Ks[j][d] = bf2f(qkvg[r + 1024 + kv * 64 + d]); Vs[j][d] = bf2f(qkvg[r + 1280 + kv * 64 + d]); }
        __syncthreads();
        for (int j = 0; j < 64; ++j) { const int kp = k0 + j; const int dd = kp - pos;
            if (dd >= -128 && dd <= 128) {
                float s = 0.f;
#pragma unroll
                for (int d = 0; d < 64; ++d) s += q[d] * Ks[j][d];
                const float mn = fmaxf(mx, s); const float a = __expf(mx - mn), p = __expf(s - mn);
                l = l * a + p;
#pragma unroll
                for (int d = 0; d < 64; ++d) o[d] = o[d] * a + p * Vs[j][d];
                mx = mn; } }
    }
    const float il = 1.0f / l; bf16_t* op = qkvg + (size_t)m * QKVG_W + h * 64;
#pragma unroll
    for (int d = 0; d < 64; ++d) op[d] = f2bf(o[d] * il);
}
__global__ void shortconv_hv_kernel(const bf16_t* hyt, const float* cw, const float* cb, bf16_t* ut0) {
    const int m = blockIdx.x * 256 + threadIdx.x, c = blockIdx.y; int st, L, pos; seq_of_row(m, st, L, pos);
    const bf16_t* r = hyt + (size_t)c * MTOK + m;
    const float a = pos > 0 ? bf2f(r[-1]) : 0.f, b = bf2f(r[0]), d = pos < L - 1 ? bf2f(r[1]) : 0.f;
    ut0[(size_t)c * MTOK + m] = f2bf(a * cw[c] + b * cw[3072 + c] + d * cw[6144 + c] + cb[c]);
}
__global__ void filt_h2_kernel(const float* w1, const float* b1, const float* f1, const float* w2, const float* b2, const float* f2, float* H2, int L) {
    __shared__ float z[33]; __shared__ float h1[64];
    const int pos = blockIdx.x, j = threadIdx.x;
    if (j < 33) { float v;
        if (j == 0) v = (float)pos / (float)(L - 1);
        else { const int k = (j - 1) & 15; const float band = 1e-4f + (float)k * ((15.0f - 1e-4f) / 15.0f);
               const float w = 6.283185307179586f * (float)pos / (float)L; const float ang = w * band;
               v = (j <= 16) ? cosf(ang) : -sinf(ang); }
        z[j] = v; }
    __syncthreads();
    float a = b1[j]; for (int i = 0; i < 33; ++i) a += z[i] * w1[i * 64 + j];
    h1[j] = sinf(f1[j] * a);
    __syncthreads();
    float c = b2[j]; for (int i = 0; i < 64; ++i) c += h1[i] * w2[i * 64 + j];
    H2[pos * 64 + j] = sinf(f2[j] * c);
}
__global__ void filt_taps_kernel(const float* H2, const float* w3, const float* decay, int order, bf16_t* F, float* nrm, int L) {
    const int x = blockIdx.x * 256 + threadIdx.x, c = blockIdx.y; const int lag = x - L;
    const int dir = (lag >= 0) ? 0 : 1; int p = lag >= 0 ? lag : -lag; const bool extra = (x == 0); if (extra) p = 0;
    const int f = order * 2048 + dir * 1024 + c;
    float a = 0.f; const float* h = H2 + (size_t)p * 64;
    for (int i = 0; i < 64; ++i) a += h[i] * w3[(size_t)i * 4096 + f];
    const float t = (float)p / (float)(L - 1);
    const float v = a * __expf(-t * fabsf(decay[f]));
    F[(size_t)c * 2 * L + x] = extra ? (bf16_t)0 : f2bf(v);
    float s = fabsf(v);
    for (int o = 1; o < 64; o <<= 1) s += __shfl_xor(s, o);
    __shared__ float red[4]; if ((threadIdx.x & 63) == 0) red[threadIdx.x >> 6] = s; __syncthreads();
    if (threadIdx.x == 0) atomicAdd(nrm + c, red[0] + red[1] + red[2] + red[3]);
}
__global__ void __launch_bounds__(256) conv_naive_kernel(const bf16_t* U, const bf16_t* F, const float* nrm, const float* dvec, const bf16_t* hyt, const float* cw, const float* cb,
                                                        int gate_off, bf16_t* Z, int seq_start0, int L) {
    const int tb = blockIdx.x * 256 + threadIdx.x, t0 = tb * 8, c = blockIdx.y, base = seq_start0 + blockIdx.z * L;
    const bf16_t* u = U + (size_t)c * MTOK + base; const bf16_t* f = F + (size_t)c * 2 * L + L;
    float acc[8]; for (int i = 0; i < 8; ++i) acc[i] = 0.f;
    float W[16];
    { const u32x4_t w = *(const u32x4_t*)(f + t0);
      for (int e = 0; e < 4; ++e) { W[8 + 2 * e] = __uint_as_float(w[e] << 16); W[9 + 2 * e] = __uint_as_float(w[e] & 0xffff0000u); } }
    for (int s = 0; s < L; s += 8) {
        const u32x4_t wn = *(const u32x4_t*)(f + (t0 - s - 8));
        const u32x4_t uu = *(const u32x4_t*)(u + s);
#pragma unroll
        for (int e = 0; e < 4; ++e) { W[2 * e] = __uint_as_float(wn[e] << 16); W[2 * e + 1] = __uint_as_float(wn[e] & 0xffff0000u); }
        float uv[8];
#pragma unroll
        for (int e = 0; e < 4; ++e) { uv[2 * e] = __uint_as_float(uu[e] << 16); uv[2 * e + 1] = __uint_as_float(uu[e] & 0xffff0000u); }
#pragma unroll
        for (int k = 0; k < 8; ++k)
#pragma unroll
            for (int i = 0; i < 8; ++i) acc[i] += uv[k] * W[8 + i - k];
#pragma unroll
        for (int j = 0; j < 8; ++j) W[8 + j] = W[j];
    }
    const float inv = 1.0f / nrm[c], dd = dvec[c]; const int gc = gate_off + c;
    const bf16_t* hr = hyt + (size_t)gc * MTOK + base; const float w0 = cw[gc], w1 = cw[3072 + gc], w2 = cw[6144 + gc], bb = cb[gc];
    for (int i = 0; i < 8; ++i) { const int t = t0 + i;
        const float y = acc[i] * inv + dd * bf2f(u[t]);
        const float gate = (t > 0 ? bf2f(hr[t - 1]) : 0.f) * w0 + bf2f(hr[t]) * w1 + (t < L - 1 ? bf2f(hr[t + 1]) : 0.f) * w2 + bb;
        Z[(size_t)c * MTOK + base + t] = f2bf(gate * y); }
}
__global__ void norm_gate_kernel(const bf16_t* qkvg, const bf16_t* gh, const bf16_t* zt, const float* ag, const float* hg, bf16_t* a2) {
    const int m = blockIdx.x, tid = threadIdx.x; __shared__ float red[8];
    float a[4], z[4]; float sa = 0.f, sz = 0.f;
    for (int i = 0; i < 4; ++i) { const int j = tid + 256 * i; a[i] = bf2f(qkvg[(size_t)m * QKVG_W + j]); z[i] = bf2f(zt[(size_t)j * MTOK + m]); sa += a[i] * a[i]; sz += z[i] * z[i]; }
    for (int o = 1; o < 64; o <<= 1) { sa += __shfl_xor(sa, o); sz += __shfl_xor(sz, o); }
    if ((tid & 63) == 0) { red[tid >> 6] = sa; red[4 + (tid >> 6)] = sz; } __syncthreads();
    const float ra = rsqrtf((red[0] + red[1] + red[2] + red[3]) * (1.0f / 1024.0f) + 1e-5f), rz = rsqrtf((red[4] + red[5] + red[6] + red[7]) * (1.0f / 1024.0f) + 1e-5f);
    for (int i = 0; i < 4; ++i) { const int j = tid + 256 * i;
        a2[(size_t)m * DMOD + j] = f2bf(a[i] * ra * ag[j] * bf2f(qkvg[(size_t)m * QKVG_W + 1536 + j]));
        a2[(size_t)m * DMOD + 1024 + j] = f2bf(z[i] * rz * hg[j] * bf2f(gh[(size_t)m * 1024 + j])); }
}

constexpr size_t MiB = 1u << 20;
constexpr size_t WS_WIN = 1 * MiB, WS_WOUT = 27 * MiB, WS_SMALL = 35 * MiB, WS_HB = 40 * MiB, WS_QKVG = 136 * MiB, WS_GH = 256 * MiB, WS_HYT = 304 * MiB, WS_FILT = 448 * MiB, WS_END = 488 * MiB;

extern "C" void kernel_launch(void* const* d_in, const int* in_sizes, int n_in, void* d_out, int out_size, void* d_ws, size_t ws_size, hipStream_t stream) {
    if (n_in != 22 || out_size != MTOK * DMOD || ws_size < WS_END) { fprintf(stderr, "kernel_launch: unexpected shapes or workspace (%d inputs, out %d, ws %zu)\n", n_in, out_size, ws_size); return; }
    static bool attr_done = false;
    if (!attr_done) { hipFuncSetAttribute((const void*)gemm_in_kernel, hipFuncAttributeMaxDynamicSharedMemorySize, pg8::STAGE_BYTES);
                      hipFuncSetAttribute((const void*)gemm_out_kernel, hipFuncAttributeMaxDynamicSharedMemorySize, pg8::STAGE_BYTES); attr_done = true; }
    const float* x_prompt = (const float*)d_in[0]; const float* x_sample = (const float*)d_in[1];
    const float* emb_g = (const float*)d_in[2]; const float* emb_b = (const float*)d_in[3];
    const float* w_in = (const float*)d_in[4]; const float* sink = (const float*)d_in[5]; const float* conv_w = (const float*)d_in[6]; const float* conv_b = (const float*)d_in[7];
    const float* fw1 = (const float*)d_in[8]; const float* fb1 = (const float*)d_in[9]; const float* ff1 = (const float*)d_in[10]; const float* fw2 = (const float*)d_in[11];
    const float* fb2 = (const float*)d_in[12]; const float* ff2 = (const float*)d_in[13]; const float* fw3 = (const float*)d_in[14]; const float* fdec = (const float*)d_in[15];
    const float* hyd = (const float*)d_in[16]; const float* ang = (const float*)d_in[17]; const float* hng = (const float*)d_in[18]; const float* w_out = (const float*)d_in[19];
    const float* lng = (const float*)d_in[20]; const float* lnb = (const float*)d_in[21];
    unsigned char* ws = (unsigned char*)d_ws; float* dout = (float*)d_out;
    bf16_t* WIN = (bf16_t*)(ws + WS_WIN); bf16_t* WOUT = (bf16_t*)(ws + WS_WOUT); bf16_t* HB = (bf16_t*)(ws + WS_HB); bf16_t* QKVG = (bf16_t*)(ws + WS_QKVG);
    bf16_t* GH = (bf16_t*)(ws + WS_GH); bf16_t* HYT = (bf16_t*)(ws + WS_HYT); bf16_t* FILT = (bf16_t*)(ws + WS_FILT);
    float* H2P = (float*)(ws + WS_SMALL); float* H2S = (float*)(ws + WS_SMALL + 2 * MiB); float* NRM = (float*)(ws + WS_SMALL + 3 * MiB);
    bf16_t* UT0 = HB; bf16_t* UT1 = HB + (size_t)1024 * MTOK; bf16_t* ZT = HYT; bf16_t* A2 = HYT + (size_t)1024 * MTOK;
    bf16_t* FP = FILT; bf16_t* FS = FILT + (size_t)1024 * 2 * LP;

    ln_rows_kernel<<<MTOK, 256, 0, stream>>>(x_prompt, x_sample, LP, emb_g, emb_b, dout, HB);
    for (int l = 0; l < 2; ++l) {
        transpose_w_kernel<<<dim3(DIN / 32, DMOD / 32), 256, 0, stream>>>(w_in + (size_t)l * DMOD * DIN, WIN, DMOD, DIN);
        transpose_w_kernel<<<dim3(DMOD / 32, DMOD / 32), 256, 0, stream>>>(w_out + (size_t)l * DMOD * DMOD, WOUT, DMOD, DMOD);
        gemm_in_kernel<<<256, 512, pg8::STAGE_BYTES, stream>>>(HB, WIN, QKVG, GH, HYT);
        rope_kernel<<<(MTOK * 160 + 255) / 256, 256, 0, stream>>>(QKVG);
        attn_naive_kernel<<<dim3(MTOK / 128, 16), 128, 0, stream>>>(QKVG, sink + l * 16);
        shortconv_hv_kernel<<<dim3(MTOK / 256, 1024), 256, 0, stream>>>(HYT, conv_w + (size_t)l * 3 * 3072, conv_b + (size_t)l * 3072, UT0);
        filt_h2_kernel<<<LP, 64, 0, stream>>>(fw1 + l * 33 * 64, fb1 + l * 64, ff1 + l * 64, fw2 + l * 64 * 64, fb2 + l * 64, ff2 + l * 64, H2P, LP);
        filt_h2_kernel<<<LS, 64, 0, stream>>>(fw1 + l * 33 * 64, fb1 + l * 64, ff1 + l * 64, fw2 + l * 64 * 64, fb2 + l * 64, ff2 + l * 64, H2S, LS);
        for (int o = 0; o < 2; ++o) {
            hipMemsetAsync(NRM, 0, 2 * 1024 * sizeof(float), stream);
            filt_taps_kernel<<<dim3(2 * LP / 256, 1024), 256, 0, stream>>>(H2P, fw3 + (size_t)l * 64 * 4096, fdec + (size_t)l * 4096, o, FP, NRM, LP);
            filt_taps_kernel<<<dim3(2 * LS / 256, 1024), 256, 0, stream>>>(H2S, fw3 + (size_t)l * 64 * 4096, fdec + (size_t)l * 4096, o, FS, NRM + 1024, LS);
            const bf16_t* U = o == 0 ? UT0 : UT1; bf16_t* Z = o == 0 ? UT1 : ZT;
            conv_naive_kernel<<<dim3(LP / 8 / 256, 1024, 1), 256, 0, stream>>>(U, FP, NRM, hyd + (size_t)l * 2048 + o * 1024, HYT, conv_w + (size_t)l * 3 * 3072, conv_b + (size_t)l * 3072, 1024 * (o + 1), Z, 0, LP);
            conv_naive_kernel<<<dim3(LS / 8 / 256, 1024, 8), 256, 0, stream>>>(U, FS, NRM + 1024, hyd + (size_t)l * 2048 + o * 1024, HYT, conv_w + (size_t)l * 3 * 3072, conv_b + (size_t)l * 3072, 1024 * (o + 1), Z, LP, LS);
        }
        norm_gate_kernel<<<MTOK, 256, 0, stream>>>(QKVG, GH, ZT, ang + l * 1024, hng + l * 1024, A2);
        gemm_out_kernel<<<256, 512, pg8::STAGE_BYTES, stream>>>(A2, WOUT, dout);
        ln_rows_kernel<<<MTOK, 256, 0, stream>>>(dout, dout, MTOK, lng + l * DMOD, lnb + l * DMOD, dout, HB);
    }
}
```

```cpp
#include <hip/hip_runtime.h>
#include <cstdio>
#include <cstdint>
namespace pg8 {
#define PG8_LAS __attribute__((address_space(3)))
typedef unsigned short bf16_t;
typedef short bf16x8 __attribute__((ext_vector_type(8)));
typedef float f32x4 __attribute__((ext_vector_type(4)));
typedef unsigned u32x4 __attribute__((ext_vector_type(4)));
constexpr int BM = 256, BK = 64, HALF = 128, HTB = HALF * BK * 2  , STAGE_BYTES = 8 * HTB, NXCD = 8, WGM = 8;

__host__ __device__ __forceinline__ int lds_byte(int r, int c) { const int st = (r >> 4) * 2 + (c >> 5), rr = r & 15, cc = c & 31, ob = rr * 64 + cc * 2; return st * 1024 + (ob ^ (((ob >> 9) & 1) << 5)); }
__host__ __device__ __forceinline__ void stage_rc(int b, int& R, int& C) { const int st = b / 1024, sb = b % 1024, swz = sb ^ (((sb >> 9) & 1) << 5); R = (st >> 1) * 16 + swz / 64; C = (st & 1) * 32 + (swz % 64) / 2; }
__host__ __device__ __forceinline__ int perm32(int rho) { const int n = rho >> 4, i = rho & 15; return 8 * (i >> 2) + 4 * n + (i & 3); }

struct Unit { int pm, pn; };
struct Gemm { const bf16_t* A; const bf16_t* Bt; int M, N, K; };

struct StaticOrder {
    int nM, nN, nwg, G, c;
    __host__ __device__ void init(int M, int N, int G_, int c_) { nM = M / BM; nN = N / BM; nwg = nM * nN; G = G_; c = c_; }
    __host__ __device__ bool next(int i, Unit& u) const {
        const long L = (long)i * G + c; if (L >= nwg) return false;
        int wgid = (int)L; { const int q = nwg / NXCD, r = nwg % NXCD, xcd = wgid % NXCD, off = wgid / NXCD; wgid = (xcd < r ? xcd * (q + 1) : r * (q + 1) + (xcd - r) * q) + off; }
        const int nig = WGM * nN, gid = wgid / nig, fm = gid * WGM, gsz = (nM - fm) < WGM ? (nM - fm) : WGM;
        u.pm = fm + ((wgid % nig) % gsz); u.pn = (wgid % nig) / gsz; return true;
    }
    __device__ __forceinline__ void a_ready(const Unit&) const {}
    __device__ __forceinline__ void done(const Unit&) const {}
};

__device__ __forceinline__ unsigned cvt_pk_bf16(float lo, float hi) { unsigned r; asm volatile("v_cvt_pk_bf16_f32 %0, %1, %2" : "=v"(r) : "v"(lo), "v"(hi)); return r; }
typedef float f32x2 __attribute__((ext_vector_type(2)));
__device__ __forceinline__ f32x2 gelu_pk(f32x2 v) {
    const f32x2 av = __builtin_elementwise_abs(v), d = av * 0.2316418882f + 1.0f;
    f32x2 t; t.x = __builtin_amdgcn_rcpf(d.x); t.y = __builtin_amdgcn_rcpf(d.y);
    f32x2 q = t * 0.5307027145f + (-0.7265760135f); q = q * t + 0.7107068705f; q = q * t + (-0.142248368f); q = q * t + 0.127414796f; q = q * t;
    const f32x2 s = (v * v) * (-0.72134752044f);
    f32x2 e; e.x = __builtin_amdgcn_exp2f(s.x); e.y = __builtin_amdgcn_exp2f(s.y);
    const f32x2 m = v * (q * e), r = v - m;
    f32x2 o; o.x = v.x < 0.f ? m.x : r.x; o.y = v.y < 0.f ? m.y : r.y; return o;
}

template <int ACT  > struct EpiBf16 {
    static constexpr bool PERM = true, AFTER_DRAIN = false; static_assert(ACT == 0 || ACT == 1, "EpiBf16: ACT is 0 (none) or 1 (gelu_pk)");
    bf16_t* O; int ldc; const float* bias; int split_cols; size_t split_stride; float scale0;
    __device__ __forceinline__ void operator()(const f32x4 (&acc)[2][2][4][2], const Unit& u, int wr, int wc, int fr, int fq) const {
        const int row0 = u.pm * BM + wr * 64 + fr; int colt = u.pn * BM; bf16_t* base = O;
        float sc = 1.f; if (split_cols) { const int t = colt / split_cols; base += (size_t)t * split_stride; colt -= t * split_cols; if (t == 0) sc = scale0; }
        const int col0 = colt + wc * 32 + 8 * fq, bcol0 = u.pn * BM + wc * 32 + 8 * fq;
        f32x4 bv[2][2];
#pragma unroll
        for (int bj = 0; bj < 2; ++bj)
#pragma unroll
            for (int n = 0; n < 2; ++n) bv[bj][n] = bias ? *(const f32x4*)(bias + bcol0 + bj * HALF + 4 * n) : (f32x4){0.f, 0.f, 0.f, 0.f};
#pragma unroll
        for (int ai = 0; ai < 2; ++ai)
#pragma unroll
            for (int m = 0; m < 4; ++m) { bf16_t* rowp = base + (size_t)(row0 + ai * HALF + m * 16) * ldc + col0;
#pragma unroll
                for (int bj = 0; bj < 2; ++bj) { f32x4 v0 = acc[ai][bj][m][0] + bv[bj][0], v1 = acc[ai][bj][m][1] + bv[bj][1];
                    if (ACT == 1) { f32x2 a = gelu_pk((f32x2){v0[0], v0[1]}), b = gelu_pk((f32x2){v0[2], v0[3]}), c = gelu_pk((f32x2){v1[0], v1[1]}), d = gelu_pk((f32x2){v1[2], v1[3]});
                        v0 = (f32x4){a.x, a.y, b.x, b.y}; v1 = (f32x4){c.x, c.y, d.x, d.y}; }
                    v0 = v0 * sc; v1 = v1 * sc; u32x4 w; w.x = cvt_pk_bf16(v0[0], v0[1]); w.y = cvt_pk_bf16(v0[2], v0[3]); w.z = cvt_pk_bf16(v1[0], v1[1]); w.w = cvt_pk_bf16(v1[2], v1[3]);
                    *(u32x4*)(rowp + bj * HALF) = w; } }
    }
};

constexpr int MTOK = 24576, LP = 8192, LS = 2048, DMOD = 2048, DIN = 6656;
constexpr int QKVG_W = 2560;
constexpr float DN_ALPHA_F = 1.41421356237f;

__device__ __forceinline__ float silu_f(float x) { return x / (1.0f + __expf(-x)); }

struct EpiIn {
    static constexpr bool PERM = true, AFTER_DRAIN = false;
    bf16_t* qkvg; bf16_t* gh; bf16_t* hyt;
    __device__ __forceinline__ void operator()(const f32x4 (&acc)[2][2][4][2], const Unit& u, int wr, int wc, int fr, int fq) const {
        const int row0 = u.pm * BM + wr * 64 + fr; const int colt = u.pn * BM;
#pragma unroll
        for (int ai = 0; ai < 2; ++ai)
#pragma unroll
            for (int m = 0; m < 4; ++m) { const int row = row0 + ai * HALF + m * 16;
#pragma unroll
                for (int bj = 0; bj < 2; ++bj) { f32x4 v0 = acc[ai][bj][m][0], v1 = acc[ai][bj][m][1];
                    const int c0 = colt + bj * HALF + wc * 32 + 8 * fq;
                    if (colt < 2560) {
                        if (colt >= 1536) { for (int e = 0; e < 4; ++e) { v0[e] = silu_f(v0[e]); v1[e] = silu_f(v1[e]); } }
                        u32x4 w; w.x = cvt_pk_bf16(v0[0], v0[1]); w.y = cvt_pk_bf16(v0[2], v0[3]); w.z = cvt_pk_bf16(v1[0], v1[1]); w.w = cvt_pk_bf16(v1[2], v1[3]);
                        *(u32x4*)(qkvg + (size_t)row * QKVG_W + c0) = w;
                    } else if (colt < 5632) {
                        u32x4 w; w.x = cvt_pk_bf16(v0[0], v0[1]); w.y = cvt_pk_bf16(v0[2], v0[3]); w.z = cvt_pk_bf16(v1[0], v1[1]); w.w = cvt_pk_bf16(v1[2], v1[3]);
                        const int ch = c0 - 2560;
                        bf16_t* p = hyt + (size_t)ch * MTOK + row;
                        p[0] = (bf16_t)(w.x & 0xffff); p[(size_t)MTOK] = (bf16_t)(w.x >> 16); p[(size_t)2 * MTOK] = (bf16_t)(w.y & 0xffff); p[(size_t)3 * MTOK] = (bf16_t)(w.y >> 16);
                        p[(size_t)4 * MTOK] = (bf16_t)(w.z & 0xffff); p[(size_t)5 * MTOK] = (bf16_t)(w.z >> 16); p[(size_t)6 * MTOK] = (bf16_t)(w.w & 0xffff); p[(size_t)7 * MTOK] = (bf16_t)(w.w >> 16);
                    } else {
                        for (int e = 0; e < 4; ++e) { v0[e] = silu_f(v0[e]); v1[e] = silu_f(v1[e]); }
                        u32x4 w; w.x = cvt_pk_bf16(v0[0], v0[1]); w.y = cvt_pk_bf16(v0[2], v0[3]); w.z = cvt_pk_bf16(v1[0], v1[1]); w.w = cvt_pk_bf16(v1[2], v1[3]);
                        *(u32x4*)(gh + (size_t)row * 1024 + (c0 - 5632)) = w;
                    } } }
    }
};
struct EpiOut {
    static constexpr bool PERM = true, AFTER_DRAIN = false;
    float* dout;
    __device__ __forceinline__ void operator()(const f32x4 (&acc)[2][2][4][2], const Unit& u, int wr, int wc, int fr, int fq) const {
        const int row0 = u.pm * BM + wr * 64 + fr; const int colt = u.pn * BM;
#pragma unroll
        for (int ai = 0; ai < 2; ++ai)
#pragma unroll
            for (int m = 0; m < 4; ++m) { const int row = row0 + ai * HALF + m * 16;
#pragma unroll
                for (int bj = 0; bj < 2; ++bj) { const int c0 = colt + bj * HALF + wc * 32 + 8 * fq;
                    float* p = dout + (size_t)row * DMOD + c0;
                    f32x4 r0 = *(const f32x4*)p, r1 = *(const f32x4*)(p + 4);
                    r0 = r0 * DN_ALPHA_F + acc[ai][bj][m][0]; r1 = r1 * DN_ALPHA_F + acc[ai][bj][m][1];
                    *(f32x4*)p = r0; *(f32x4*)(p + 4) = r1; } }
    }
};
template <class Epi, class Sched, bool ALIGN_EPI = false, bool SP2 = false>
__device__ __forceinline__ void gemm_phase(PG8_LAS unsigned char* lds, const Gemm g, const Sched& S, const Epi& E) {
    int tid_o = threadIdx.x; asm volatile("" : "+v"(tid_o));
    const int tid = tid_o, wid = __builtin_amdgcn_readfirstlane(tid >> 6), lane = tid & 63, wr = wid >> 2, wc = wid & 3, fr = lane & 15, fq = lane >> 4;
    const int K = g.K, nt = K / BK;
    unsigned voffA[2], voffB[2];
#pragma unroll
    for (int i = 0; i < 2; ++i) { int R, C; stage_rc(tid * 16 + i * 8192, R, C); const int Rb = Epi::PERM ? ((R & ~31) + perm32(R & 31)) : R;
        voffA[i] = (unsigned)(R * K + C) * 2u; voffB[i] = (unsigned)(Rb * K + C) * 2u; }
    const size_t kstep = (size_t)(BK * 2);
    const size_t hstep = (size_t)HALF * K * 2;
    const size_t tstep = 2 * hstep;
    const unsigned ldsw = (unsigned)wid * 1024u;
    const int aoff = lds_byte(wr * 64 + fr, fq * 8), boff = lds_byte(wc * 32 + fr, fq * 8);
#define PG8_SA(b, h) (((b) * 2 + (h)) * HTB)
#define PG8_SB(b, h) ((4 + (b) * 2 + (h)) * HTB)
#define PG8_STAGE(bufoff, gbase, voff) do { _Pragma("unroll") for (int _i = 0; _i < 2; ++_i) \
        __builtin_amdgcn_global_load_lds((const unsigned*)((const char*)(gbase) + (voff)[_i]), (PG8_LAS unsigned*)(lds + (bufoff) + ldsw + _i * 8192), 16, 0, 0); } while (0)
#define PG8_LDA(dst, b, h) do { _Pragma("unroll") for (int m = 0; m < 4; ++m) _Pragma("unroll") for (int k = 0; k < 2; ++k) dst[m][k] = *(const PG8_LAS bf16x8*)(lds + PG8_SA(b, h) + aoff + m * 2048 + k * 1024); } while (0)
#define PG8_LDB(dst, b, h) do { _Pragma("unroll") for (int n = 0; n < 2; ++n) _Pragma("unroll") for (int k = 0; k < 2; ++k) dst[n][k] = *(const PG8_LAS bf16x8*)(lds + PG8_SB(b, h) + boff + n * 2048 + k * 1024); } while (0)
#define PG8_MMA(ai, bj, At, Bt) do { __builtin_amdgcn_s_setprio(1); _Pragma("unroll") for (int m = 0; m < 4; ++m) _Pragma("unroll") for (int n = 0; n < 2; ++n) _Pragma("unroll") for (int k = 0; k < 2; ++k) \
        acc[ai][bj][m][n] = __builtin_amdgcn_mfma_f32_16x16x32_bf16(Bt[n][k], At[m][k], acc[ai][bj][m][n], 0, 0, 0); __builtin_amdgcn_s_setprio(0); } while (0)
#define PG8_WAIT_V(n) asm volatile("s_waitcnt vmcnt(" #n ")" ::: "memory")
#define PG8_WAIT_L(n) asm volatile("s_waitcnt lgkmcnt(" #n ")" ::: "memory")
#define PG8_BAR __builtin_amdgcn_s_barrier()
#define PG8_SCHED __builtin_amdgcn_sched_barrier(0)
    Unit cur, nxt; int ui = 0;
    if (!S.next(0, cur)) return;
    f32x4 acc[2][2][4][2];
#pragma unroll
    for (int a = 0; a < 2; ++a)
#pragma unroll
        for (int b = 0; b < 2; ++b)
#pragma unroll
            for (int m = 0; m < 4; ++m)
#pragma unroll
                for (int n = 0; n < 2; ++n) acc[a][b][m][n] = (f32x4){0.f, 0.f, 0.f, 0.f};
    bf16x8 At[4][2], B0[2][2], B1[2][2];
    const char* cA = (const char*)g.A + (size_t)cur.pm * tstep; const char* cB = (const char*)g.Bt + (size_t)cur.pn * tstep;
    S.a_ready(cur);
    if constexpr (SP2) {
        PG8_STAGE(PG8_SB(0, 0), cB, voffB); PG8_STAGE(PG8_SB(0, 1), cB + hstep, voffB); PG8_STAGE(PG8_SA(0, 0), cA, voffA); PG8_STAGE(PG8_SA(0, 1), cA + hstep, voffA);
        if (wr == 1) PG8_BAR;
        PG8_WAIT_V(2); PG8_BAR;
        PG8_STAGE(PG8_SB(1, 0), cB + kstep, voffB); PG8_STAGE(PG8_SA(1, 0), cA + kstep, voffA); PG8_STAGE(PG8_SB(1, 1), cB + hstep + kstep, voffB);
        PG8_WAIT_V(6); PG8_BAR;
    } else {
        PG8_STAGE(PG8_SB(0, 0), cB, voffB); PG8_STAGE(PG8_SA(0, 0), cA, voffA); PG8_STAGE(PG8_SB(0, 1), cB + hstep, voffB); PG8_STAGE(PG8_SA(0, 1), cA + hstep, voffA);
        if (wr == 1) PG8_BAR;
        PG8_WAIT_V(4); PG8_BAR;
        PG8_STAGE(PG8_SB(1, 0), cB + kstep, voffB); PG8_STAGE(PG8_SA(1, 0), cA + kstep, voffA); PG8_STAGE(PG8_SB(1, 1), cB + hstep + kstep, voffB);
        PG8_WAIT_V(6); PG8_BAR;
    }
    for (;;) {
        const bool has_next = S.next(ui + 1, nxt);
        const char* nA = has_next ? (const char*)g.A + (size_t)nxt.pm * tstep : cA; const char* nB = has_next ? (const char*)g.Bt + (size_t)nxt.pn * tstep : cB;
        for (int t = 0; t < nt; t += 2) {
            const bool last = (t == nt - 2);
            const char* a1 = cA + (size_t)(t + 1) * kstep;
            const char* a2 = last ? nA : cA + (size_t)(t + 2) * kstep; const char* b2 = last ? nB : cB + (size_t)(t + 2) * kstep;
            const char* a3 = a2 + kstep; const char* b3 = b2 + kstep;
            if (last && has_next) S.a_ready(nxt);
            if constexpr (SP2) {
            PG8_LDB(B0, 0, 0); PG8_LDB(B1, 0, 1); PG8_SCHED; PG8_LDA(At, 0, 0); PG8_STAGE(PG8_SA(1, 1), a1 + hstep, voffA);
            PG8_WAIT_V(8); PG8_WAIT_L(0); PG8_BAR; PG8_MMA(0, 0, At, B0); PG8_MMA(0, 1, At, B1); PG8_BAR; PG8_SCHED;
            PG8_LDA(At, 0, 1); PG8_STAGE(PG8_SB(0, 0), b2, voffB); PG8_STAGE(PG8_SB(0, 1), b2 + hstep, voffB); PG8_STAGE(PG8_SA(0, 0), a2, voffA);
            PG8_WAIT_V(8); PG8_WAIT_L(0); PG8_BAR; PG8_MMA(1, 0, At, B0); PG8_MMA(1, 1, At, B1); PG8_BAR; PG8_SCHED;
            PG8_LDB(B0, 1, 0); PG8_LDB(B1, 1, 1); PG8_SCHED; PG8_LDA(At, 1, 0); PG8_STAGE(PG8_SA(0, 1), a2 + hstep, voffA);
            PG8_WAIT_V(8); PG8_WAIT_L(0); PG8_BAR; PG8_MMA(0, 0, At, B0); PG8_MMA(0, 1, At, B1); PG8_BAR; PG8_SCHED;
            PG8_LDA(At, 1, 1); PG8_STAGE(PG8_SB(1, 0), b3, voffB); PG8_STAGE(PG8_SB(1, 1), b3 + hstep, voffB); PG8_STAGE(PG8_SA(1, 0), a3, voffA);
            PG8_WAIT_V(8); PG8_WAIT_L(0); PG8_BAR; PG8_MMA(1, 0, At, B0); PG8_MMA(1, 1, At, B1); PG8_BAR; PG8_SCHED;
            } else {
            PG8_LDB(B0, 0, 0); PG8_SCHED; PG8_LDA(At, 0, 0); PG8_STAGE(PG8_SA(1, 1), a1 + hstep, voffA);
            PG8_WAIT_L(8); PG8_BAR; PG8_WAIT_L(0); PG8_MMA(0, 0, At, B0); PG8_BAR; PG8_SCHED;
            PG8_LDB(B1, 0, 1); PG8_STAGE(PG8_SB(0, 0), b2, voffB);
            PG8_BAR; PG8_WAIT_L(0); PG8_MMA(0, 1, At, B1); PG8_BAR;
            PG8_LDA(At, 0, 1); PG8_STAGE(PG8_SA(0, 0), a2, voffA);
            PG8_BAR; PG8_WAIT_L(0); PG8_MMA(1, 0, At, B0); PG8_BAR; PG8_SCHED;
            PG8_STAGE(PG8_SB(0, 1), b2 + hstep, voffB);
            PG8_WAIT_V(6); PG8_BAR; PG8_MMA(1, 1, At, B1); PG8_BAR;
            PG8_LDB(B0, 1, 0); PG8_SCHED; PG8_LDA(At, 1, 0); PG8_STAGE(PG8_SA(0, 1), a2 + hstep, voffA);
            PG8_WAIT_L(8); PG8_BAR; PG8_WAIT_L(0); PG8_MMA(0, 0, At, B0); PG8_BAR; PG8_SCHED;
            PG8_LDB(B1, 1, 1); PG8_STAGE(PG8_SB(1, 0), b3, voffB);
            PG8_BAR; PG8_WAIT_L(0); PG8_MMA(0, 1, At, B1); PG8_BAR;
            PG8_LDA(At, 1, 1); PG8_STAGE(PG8_SA(1, 0), a3, voffA);
            PG8_BAR; PG8_WAIT_L(0); PG8_MMA(1, 0, At, B0); PG8_BAR; PG8_SCHED;
            PG8_STAGE(PG8_SB(1, 1), b3 + hstep, voffB);
            PG8_WAIT_V(6); PG8_BAR; PG8_MMA(1, 1, At, B1); PG8_BAR;
            }
        }
        if constexpr (ALIGN_EPI) { if (wr == 0) PG8_BAR; }
        if constexpr (!Epi::AFTER_DRAIN) { E(acc, cur, wr, wc, fr, fq); S.done(cur); }
        if (!has_next) break;
#pragma unroll
        for (int a = 0; a < 2; ++a)
#pragma unroll
            for (int b = 0; b < 2; ++b)
#pragma unroll
                for (int m = 0; m < 4; ++m)
#pragma unroll
                    for (int n = 0; n < 2; ++n) acc[a][b][m][n] = (f32x4){0.f, 0.f, 0.f, 0.f};
        cur = nxt; cA = nA; cB = nB; ++ui;
        if constexpr (ALIGN_EPI) { if (wr == 1) PG8_BAR; }
    }
    PG8_WAIT_V(0);
    if constexpr (!ALIGN_EPI) { if (wr == 0) PG8_BAR; }
    PG8_BAR;
    if constexpr (Epi::AFTER_DRAIN) { E.fused(acc, cur, wr, wc, fr, fq, lds, wid, lane); S.done(cur); }
#undef PG8_SA
#undef PG8_SB
#undef PG8_STAGE
#undef PG8_LDA
#undef PG8_LDB
#undef PG8_MMA
#undef PG8_WAIT_V
#undef PG8_WAIT_L
#undef PG8_BAR
#undef PG8_SCHED
}
}
#define GAS __attribute__((address_space(1)))
#define LAS __attribute__((address_space(3)))
typedef unsigned short bf16;
typedef unsigned v4u __attribute__((ext_vector_type(4)));
typedef float f32x4 __attribute__((ext_vector_type(4)));
typedef short bf16x8 __attribute__((ext_vector_type(8)));
typedef GAS unsigned gu32;
typedef GAS unsigned long long gu64;
#define RLX_AGENT __ATOMIC_RELAXED, __HIP_MEMORY_SCOPE_AGENT
#define LDS_WAIT() asm volatile("s_waitcnt lgkmcnt(0)" ::: "memory")
#define VM_WAIT() asm volatile("s_waitcnt vmcnt(0)" ::: "memory")
__device__ __forceinline__ unsigned long long rt() { return __builtin_amdgcn_s_memrealtime(); }
__device__ __forceinline__ unsigned f2bf(float f) { unsigned u = __builtin_bit_cast(unsigned, f); return (u + 0x7fffu + ((u >> 16) & 1u)) >> 16; }
__device__ __forceinline__ unsigned pk2(float lo, float hi) { return f2bf(lo) | (f2bf(hi) << 16); }

#define XB_TMO      128
#define XB_XCNT(j)  (256  + 64 * (j))
#define XB_XSUB(j)  (1280 + 64 * (j))
#define XB_XGEN(j)  (2304 + 64 * (j))
#define XB_TOP      3328
#define XB_TOPGEN   3392
#define XCD_BAR_WORDS 3456
#define XB_SPIN_CAP (1u << 18)

__device__ __forceinline__ unsigned xb_ld(unsigned* p)              { return __hip_atomic_load(p, __ATOMIC_RELAXED, __HIP_MEMORY_SCOPE_AGENT); }
__device__ __forceinline__ unsigned xb_add(unsigned* p, unsigned v) { return __hip_atomic_fetch_add(p, v, __ATOMIC_RELAXED, __HIP_MEMORY_SCOPE_AGENT); }
__device__ __forceinline__ unsigned xb_xcc_id() { return (unsigned)__builtin_amdgcn_s_getreg((3 << 11) | 20) & 0xFu; }
#define XB_SPIN(cond, bar) do { unsigned _sp = 0; while (cond) { __builtin_amdgcn_s_sleep(1); \
    if ((++_sp & 255u) == 0u) { if (xb_ld(&(bar)[XB_TMO])) break; if (_sp > XB_SPIN_CAP) { atomicAdd(&(bar)[XB_TMO], 1u); break; } } } } while (0)

struct XcdBarrier {
    unsigned* bar; unsigned x;
    volatile LAS unsigned* st;
};

__device__ __forceinline__ XcdBarrier xcd_barrier_post(unsigned* bar, volatile LAS unsigned* st) {
    XcdBarrier b; b.bar = bar; b.x = xb_xcc_id(); b.st = st;
    if (threadIdx.x == 0) (void)xb_add(&bar[XB_XCNT(b.x)], 1u);
    return b;
}
__device__ __forceinline__ void xcd_barrier_complete(unsigned* bar, unsigned x, unsigned& nloc, unsigned& nx) {
    const unsigned G = gridDim.x * gridDim.y * gridDim.z;
    unsigned sum, cnt, mine, sp = 0u;
    for (;;) {
        sum = 0u; cnt = 0u; mine = 0u;
#pragma unroll
        for (unsigned j = 0; j < 16; ++j) { const unsigned c = xb_ld(&bar[XB_XCNT(j)]); sum += c; cnt += (c > 0u) ? 1u : 0u; mine = (j == x) ? c : mine; }
        if (sum == G) break;
        __builtin_amdgcn_s_sleep(1);
        if ((++sp & 255u) == 0u) { if (xb_ld(&bar[XB_TMO])) break; if (sp > XB_SPIN_CAP) { atomicAdd(&bar[XB_TMO], 1u); break; } }
    }
    nloc = mine > 0u ? mine : 1u; nx = cnt > 0u ? cnt : 1u;
}

__device__ __forceinline__ void xcd_barrier(const XcdBarrier& b) {
    asm volatile("s_waitcnt vmcnt(0)" ::: "memory");
    __syncthreads();
    if (threadIdx.x == 0) {
        unsigned* bar = b.bar;
        __builtin_amdgcn_s_waitcnt(0);
        unsigned nloc = b.st[0], nx = b.st[1];
        if (nloc == 0u) { xcd_barrier_complete(bar, b.x, nloc, nx); b.st[0] = nloc; b.st[1] = nx; }
        const unsigned old = xb_add(&bar[XB_XSUB(b.x)], 1u);
        const unsigned gen = old / nloc;
        if (old + 1u == (gen + 1u) * nloc) {
            __builtin_amdgcn_fence(__ATOMIC_RELEASE, "agent");
            asm volatile("s_waitcnt vmcnt(0)" ::: "memory");
            const unsigned og = xb_add(&bar[XB_TOP], 1u);
            const unsigned tg = og / nx;
            if (og + 1u == (tg + 1u) * nx) xb_add(&bar[XB_TOPGEN], 1u);
            else XB_SPIN(xb_ld(&bar[XB_TOPGEN]) == tg, bar);
            __builtin_amdgcn_fence(__ATOMIC_ACQUIRE, "agent");
            xb_add(&bar[XB_XGEN(b.x)], 1u);
            asm volatile("s_waitcnt vmcnt(0)" ::: "memory");
        } else {
            XB_SPIN(xb_ld(&bar[XB_XGEN(b.x)]) == gen, bar);
            __builtin_amdgcn_fence(__ATOMIC_ACQUIRE, "agent");
            asm volatile("s_waitcnt vmcnt(0)" ::: "memory");
        }
    }
    __syncthreads();
}

using pg8::bf16_t; using pg8::MTOK; using pg8::LP; using pg8::LS; using pg8::DMOD; using pg8::DIN; using pg8::QKVG_W;
typedef unsigned u32x4_t __attribute__((ext_vector_type(4)));
typedef float f32x4_t __attribute__((ext_vector_type(4)));
__device__ __forceinline__ float bf2f(unsigned short b) { return __uint_as_float(((unsigned)b) << 16); }

constexpr size_t MiB = 1u << 20;
constexpr size_t WS_CTL = 0, CTL_ZERO_BYTES = 64 * 1024;
constexpr size_t WS_NRM = 512 * 1024;
constexpr size_t WS_WIN = 1 * MiB, WS_WOUT = 27 * MiB, WS_SMALL = 35 * MiB, WS_HB = 40 * MiB, WS_QKVG = 136 * MiB, WS_GH = 256 * MiB, WS_HYT = 304 * MiB, WS_FILT = 448 * MiB, WS_ROPE = 488 * MiB, WS_END = 489 * MiB;
constexpr int CW_BAR = 1024;
constexpr int RING_BYTES = 131072, LDSCTL_OFF = RING_BYTES, MISC_OFF = LDSCTL_OFF + 320, LDS_BYTES = 147456;
constexpr int NWAVES = 8, NTHR = 512;

struct Args { const float* in[22]; float* out; unsigned char* ws; };

struct Ctx {
    int tid; int G; int bx;
    unsigned char* lds_g;
    const float *x_prompt, *x_sample, *emb_g, *emb_b, *w_in, *sink, *conv_w, *conv_b, *fw1, *fb1, *ff1, *fw2, *fb2, *ff2, *fw3, *fdec, *hyd, *ang, *hng, *w_out, *lng, *lnb;
    float* dout; bf16_t *WIN, *WOUT, *HB, *QKVG, *GH, *HYT, *FILT, *UT0, *UT1, *ZT, *A2, *FP, *FS; float *H2, *NRM, *ROPE;
};
__device__ __forceinline__ void seq_of_row(int m, int& start, int& L, int& pos) {
    if (m < LP) { start = 0; L = LP; pos = m; } else { const int r = m - LP; start = LP + (r / LS) * LS; L = LS; pos = r % LS; }
}
#define OPAQUE_TID(t) int t = threadIdx.x; asm volatile("" : "+v"(t))
#define VB_SETUP(BS) OPAQUE_TID(otid_); const int per_ = NTHR / (BS); const int vsub = otid_ / (BS); const int vtid = otid_ % (BS); (void)vsub; (void)vtid; (void)per_
#define VB_FOR(nvb) for (int it_ = C.bx; it_ * per_ < (nvb); it_ += C.G)

__device__ __forceinline__ void ph_transpose(const Ctx& C, const float* W, bf16_t* WT, int K, int N) {
    VB_SETUP(256); float* t = (float*)C.lds_g + vsub * (32 * 33); const int nbx = N / 32, nvb = nbx * (K / 32);
    VB_FOR(nvb) { const int vb = it_ * per_ + vsub; const int n0 = (vb % nbx) * 32, k0 = (vb / nbx) * 32, tx = vtid & 31, ty = vtid >> 5;
        __syncthreads();
        for (int i = 0; i < 4; ++i) t[(ty + 8 * i) * 33 + tx] = W[(size_t)(k0 + ty + 8 * i) * N + n0 + tx];
        __syncthreads();
        for (int i = 0; i < 4; ++i) WT[(size_t)(n0 + ty + 8 * i) * K + k0 + tx] = (bf16_t)f2bf(t[tx * 33 + ty + 8 * i]); }
    __syncthreads();
}
__device__ __forceinline__ void ph_ln_rows(const Ctx& C, const float* in0, const float* in1, int split, const float* g, const float* b, float* outf, bf16_t* outb) {
    VB_SETUP(256); float* red = (float*)C.lds_g + vsub * 8;
    VB_FOR(MTOK) { const int m = it_ * per_ + vsub; const int tid = vtid;
        const float* src = (m < split) ? in0 + (size_t)m * DMOD : in1 + (size_t)(m - split) * DMOD;
        f32x4_t v0 = *(const f32x4_t*)(src + tid * 8), v1 = *(const f32x4_t*)(src + tid * 8 + 4);
        float s = (v0[0] + v0[1]) + (v0[2] + v0[3]) + (v1[0] + v1[1]) + (v1[2] + v1[3]);
        for (int o = 1; o < 64; o <<= 1) s += __shfl_xor(s, o);
        __syncthreads();
        if ((tid & 63) == 0) red[tid >> 6] = s;
        __syncthreads();
        const float mean = (red[0] + red[1] + red[2] + red[3]) * (1.0f / DMOD);
        v0 = v0 - mean; v1 = v1 - mean;
        float q = (v0[0] * v0[0] + v0[1] * v0[1]) + (v0[2] * v0[2] + v0[3] * v0[3]) + (v1[0] * v1[0] + v1[1] * v1[1]) + (v1[2] * v1[2] + v1[3] * v1[3]);
        for (int o = 1; o < 64; o <<= 1) q += __shfl_xor(q, o);
        if ((tid & 63) == 0) red[4 + (tid >> 6)] = q;
        __syncthreads();
        const float rstd = rsqrtf((red[4] + red[5] + red[6] + red[7]) * (1.0f / DMOD) + 1e-5f);
        const f32x4_t g0 = *(const f32x4_t*)(g + tid * 8), g1 = *(const f32x4_t*)(g + tid * 8 + 4), b0 = *(const f32x4_t*)(b + tid * 8), b1 = *(const f32x4_t*)(b + tid * 8 + 4);
        v0 = v0 * rstd * g0 + b0; v1 = v1 * rstd * g1 + b1;
        *(f32x4_t*)(outf + (size_t)m * DMOD + tid * 8) = v0; *(f32x4_t*)(outf + (size_t)m * DMOD + tid * 8 + 4) = v1;
        u32x4_t w; w.x = pk2(v0[0], v0[1]); w.y = pk2(v0[2], v0[3]); w.z = pk2(v1[0], v1[1]); w.w = pk2(v1[2], v1[3]);
        *(u32x4_t*)(outb + (size_t)m * DMOD + tid * 8) = w; }
    __syncthreads();
}
__device__ __forceinline__ void ph_rope_table(const Ctx& C) {
    OPAQUE_TID(otid_);
    for (int idx = C.bx * NTHR + otid_; idx < LP * 8; idx += C.G * NTHR) { const int pos = idx >> 3, i = idx & 7;
        const float inv = powf(500000.0f, -(float)(2 * i) / 16.0f); const float ang = (float)pos * inv;
        C.ROPE[pos * 16 + i] = cosf(ang); C.ROPE[pos * 16 + 8 + i] = sinf(ang); }
}
__device__ __forceinline__ void ph_attn_naive(const Ctx& C, const float* sink) {
    VB_SETUP(128); float* Ks = (float*)C.lds_g + vsub * 8192; float* Vs = Ks + 4096; bf16_t* qkvg = C.QKVG;
    VB_FOR(3072) { const int vb = it_ * per_ + vsub; const int qb = vb >> 4, h = vb & 15, tid = vtid, kv = h >> 2;
        const int m = qb * 128 + tid; int st, L, pos; seq_of_row(m, st, L, pos);
        const int pos0 = pos - tid;
        float q[64], o[64];
        { const bf16_t* qp = qkvg + (size_t)m * QKVG_W + h * 64;
#pragma unroll
          for (int d = 0; d < 64; ++d) { q[d] = bf2f(qp[d]); o[d] = 0.f; }
#pragma unroll
          for (int i = 0; i < 8; ++i) { const float c = C.ROPE[pos * 16 + i], s = C.ROPE[pos * 16 + 8 + i];
              const float t1 = q[i], t2 = q[i + 8]; q[i] = t1 * c - t2 * s; q[i + 8] = t2 * c + t1 * s; }
#pragma unroll
          for (int d = 0; d < 64; ++d) q[d] *= 0.125f; }
        float mx = sink[h], l = 1.0f;
        for (int kt = 0; kt < 6; ++kt) { const int k0 = pos0 - 128 + kt * 64; const bool tv = (k0 >= 0 && k0 < L);
            __syncthreads();
            if (tv) for (int e = tid; e < 64 * 64; e += 128) { const int j = e >> 6, d = e & 63; const size_t r = (size_t)(st + k0 + j) * QKVG_W;
                Ks[j * 64 + d] = bf2f(qkvg[r + 1024 + kv * 64 + d]); Vs[j * 64 + d] = bf2f(qkvg[r + 1280 + kv * 64 + d]); }
            __syncthreads();
            if (tv) for (int e = tid; e < 64 * 8; e += 128) { const int j = e >> 3, i = e & 7; const float c = C.ROPE[(k0 + j) * 16 + i], s = C.ROPE[(k0 + j) * 16 + 8 + i];
                const float t1 = Ks[j * 64 + i], t2 = Ks[j * 64 + i + 8]; Ks[j * 64 + i] = t1 * c - t2 * s; Ks[j * 64 + i + 8] = t2 * c + t1 * s; }
            __syncthreads();
            if (tv) for (int j = 0; j < 64; ++j) { const int dd = k0 + j - pos;
                if (dd >= -128 && dd <= 128) {
                    float s = 0.f;
#pragma unroll
                    for (int d = 0; d < 64; ++d) s += q[d] * Ks[j * 64 + d];
                    const float mn = fmaxf(mx, s); const float a = __expf(mx - mn), p = __expf(s - mn);
                    l = l * a + p;
#pragma unroll
                    for (int d = 0; d < 64; ++d) o[d] = o[d] * a + p * Vs[j * 64 + d];
                    mx = mn; } } }
        const float il = 1.0f / l; bf16_t* op = qkvg + (size_t)m * QKVG_W + h * 64;
#pragma unroll
        for (int d = 0; d < 64; ++d) op[d] = (bf16_t)f2bf(o[d] * il); }
    __syncthreads();
}
__device__ __forceinline__ void ph_shortconv_hv(const Ctx& C, const float* cw, const float* cb) {
    OPAQUE_TID(otid_);
    for (size_t idx = (size_t)C.bx * NTHR + otid_; idx < (size_t)1024 * MTOK; idx += (size_t)C.G * NTHR) { const int c = (int)(idx / MTOK), m = (int)(idx % MTOK);
        int st, L, pos; seq_of_row(m, st, L, pos);
        const bf16_t* r = C.HYT + (size_t)c * MTOK + m;
        const float a = pos > 0 ? bf2f(r[-1]) : 0.f, b = bf2f(r[0]), d = pos < L - 1 ? bf2f(r[1]) : 0.f;
        C.UT0[(size_t)c * MTOK + m] = (bf16_t)f2bf(a * cw[c] + b * cw[3072 + c] + d * cw[6144 + c] + cb[c]); }
}
__device__ __forceinline__ void ph_filt_h2(const Ctx& C, int l, float* H2, int L) {
    VB_SETUP(64); float* z = (float*)C.lds_g + vsub * 128; float* h1 = z + 40;
    const float* w1 = C.fw1 + l * 33 * 64; const float* b1 = C.fb1 + l * 64; const float* f1 = C.ff1 + l * 64; const float* w2 = C.fw2 + l * 64 * 64; const float* b2 = C.fb2 + l * 64; const float* f2 = C.ff2 + l * 64;
    VB_FOR(L) { const int pos = it_ * per_ + vsub, j = vtid;
        __syncthreads();
        if (j < 33) { float v;
            if (j == 0) v = (float)pos / (float)(L - 1);
            else { const int k = (j - 1) & 15; const float band = 1e-4f + (float)k * ((15.0f - 1e-4f) / 15.0f);
                   const float w = 6.283185307179586f * (float)pos / (float)L; const float ang = w * band;
                   v = (j <= 16) ? cosf(ang) : -sinf(ang); }
            z[j] = v; }
        __syncthreads();
        float a = b1[j]; for (int i = 0; i < 33; ++i) a += z[i] * w1[i * 64 + j];
        h1[j] = sinf(f1[j] * a);
        __syncthreads();
        float c = b2[j]; for (int i = 0; i < 64; ++i) c += h1[i] * w2[i * 64 + j];
        H2[pos * 64 + j] = sinf(f2[j] * c); }
    __syncthreads();
}
__device__ __forceinline__ void ph_filt_taps(const Ctx& C, int l, const float* H2, int order, bf16_t* F, float* nrm, int L) {
    VB_SETUP(256); float* red = (float*)C.lds_g + vsub * 8; const float* w3 = C.fw3 + (size_t)l * 64 * 4096; const float* decay = C.fdec + (size_t)l * 4096;
    VB_FOR(1024) { const int c = it_ * per_ + vsub; float s = 0.f;
        for (int x = vtid; x < 2 * L; x += 256) { const int lag = x - L; const int dir = (lag >= 0) ? 0 : 1; int p = lag >= 0 ? lag : -lag; const bool extra = (x == 0); if (extra) p = 0;
            const int f = order * 2048 + dir * 1024 + c;
            float a = 0.f; const float* h = H2 + (size_t)p * 64;
            for (int i = 0; i < 64; ++i) a += h[i] * w3[(size_t)i * 4096 + f];
            const float t = (float)p / (float)(L - 1);
            const float v = a * __expf(-t * fabsf(decay[f]));
            F[(size_t)c * 2 * L + x] = extra ? (bf16_t)0 : (bf16_t)f2bf(v);
            s += fabsf(v); }
        for (int o = 1; o < 64; o <<= 1) s += __shfl_xor(s, o);
        __syncthreads();
        if ((vtid & 63) == 0) red[vtid >> 6] = s;
        __syncthreads();
        if (vtid == 0) nrm[c] = red[0] + red[1] + red[2] + red[3]; }
    __syncthreads();
}
__device__ __forceinline__ void ph_conv_naive(const Ctx& C, int l, int order) {
    VB_SETUP(256); const bf16_t* U = order == 0 ? C.UT0 : C.UT1; bf16_t* Z = order == 0 ? C.UT1 : C.ZT;
    const float* dvec = C.hyd + (size_t)l * 2048 + order * 1024; const float* cw = C.conv_w + (size_t)l * 3 * 3072; const float* cb = C.conv_b + (size_t)l * 3072; const int gate_off = 1024 * (order + 1);
    VB_FOR(4096 + 8192) { const int vb = it_ * per_ + vsub; int c, base, L, tb; const bf16_t* F; const float* nrm;
        if (vb < 4096) { c = vb >> 2; tb = (vb & 3) * 256 + vtid; base = 0; L = LP; F = C.FP; nrm = C.NRM; }
        else { const int v2 = vb - 4096; c = v2 >> 3; tb = vtid; base = LP + (v2 & 7) * LS; L = LS; F = C.FS; nrm = C.NRM + 1024; }
        const int t0 = tb * 8;
        const bf16_t* u = U + (size_t)c * MTOK + base; const bf16_t* f = F + (size_t)c * 2 * L + L;
        float acc[8]; for (int i = 0; i < 8; ++i) acc[i] = 0.f;
        float W[16];
        { const u32x4_t w = *(const u32x4_t*)(f + t0);
          for (int e = 0; e < 4; ++e) { W[8 + 2 * e] = __uint_as_float(w[e] << 16); W[9 + 2 * e] = __uint_as_float(w[e] & 0xffff0000u); } }
        for (int s = 0; s < L; s += 8) {
            const u32x4_t wn = *(const u32x4_t*)(f + (t0 - s - 8));
            const u32x4_t uu = *(const u32x4_t*)(u + s);
#pragma unroll
            for (int e = 0; e < 4; ++e) { W[2 * e] = __uint_as_float(wn[e] << 16); W[2 * e + 1] = __uint_as_float(wn[e] & 0xffff0000u); }
            float uv[8];
#pragma unroll
            for (int e = 0; e < 4; ++e) { uv[2 * e] = __uint_as_float(uu[e] << 16); uv[2 * e + 1] = __uint_as_float(uu[e] & 0xffff0000u); }
#pragma unroll
            for (int k = 0; k < 8; ++k)
#pragma unroll
                for (int i = 0; i < 8; ++i) acc[i] += uv[k] * W[8 + i - k];
#pragma unroll
            for (int j = 0; j < 8; ++j) W[8 + j] = W[j];
        }
        const float inv = 1.0f / nrm[c], dd = dvec[c]; const int gc = gate_off + c;
        const bf16_t* hr = C.HYT + (size_t)gc * MTOK + base; const float w0 = cw[gc], w1 = cw[3072 + gc], w2 = cw[6144 + gc], bb = cb[gc];
        for (int i = 0; i < 8; ++i) { const int t = t0 + i;
            const float y = acc[i] * inv + dd * bf2f(u[t]);
            const float gate = (t > 0 ? bf2f(hr[t - 1]) : 0.f) * w0 + bf2f(hr[t]) * w1 + (t < L - 1 ? bf2f(hr[t + 1]) : 0.f) * w2 + bb;
            Z[(size_t)c * MTOK + base + t] = (bf16_t)f2bf(gate * y); } }
}
__device__ __forceinline__ void ph_norm_gate(const Ctx& C, int l) {
    VB_SETUP(256); float* red = (float*)C.lds_g + vsub * 8; const float* ag = C.ang + l * 1024; const float* hg = C.hng + l * 1024;
    VB_FOR(MTOK) { const int m = it_ * per_ + vsub, tid = vtid;
        float a[4], z[4]; float sa = 0.f, sz = 0.f;
        for (int i = 0; i < 4; ++i) { const int j = tid + 256 * i; a[i] = bf2f(C.QKVG[(size_t)m * QKVG_W + j]); z[i] = bf2f(C.ZT[(size_t)j * MTOK + m]); sa += a[i] * a[i]; sz += z[i] * z[i]; }
        for (int o = 1; o < 64; o <<= 1) { sa += __shfl_xor(sa, o); sz += __shfl_xor(sz, o); }
        __syncthreads();
        if ((tid & 63) == 0) { red[tid >> 6] = sa; red[4 + (tid >> 6)] = sz; }
        __syncthreads();
        const float ra = rsqrtf((red[0] + red[1] + red[2] + red[3]) * (1.0f / 1024.0f) + 1e-5f), rz = rsqrtf((red[4] + red[5] + red[6] + red[7]) * (1.0f / 1024.0f) + 1e-5f);
        for (int i = 0; i < 4; ++i) { const int j = tid + 256 * i;
            C.A2[(size_t)m * DMOD + j] = (bf16_t)f2bf(a[i] * ra * ag[j] * bf2f(C.QKVG[(size_t)m * QKVG_W + 1536 + j]));
            C.A2[(size_t)m * DMOD + 1024 + j] = (bf16_t)f2bf(z[i] * rz * hg[j] * bf2f(C.GH[(size_t)m * 1024 + j])); } }
    __syncthreads();
}

__global__ void __launch_bounds__(NTHR, 2) fwd_megakernel(Args args) {
    extern __shared__ __attribute__((aligned(16))) unsigned char lds[];
    Ctx C; C.tid = threadIdx.x; C.G = gridDim.x; C.bx = blockIdx.x; C.lds_g = lds;
    unsigned char* ws = args.ws;
    C.x_prompt = args.in[0]; C.x_sample = args.in[1]; C.emb_g = args.in[2]; C.emb_b = args.in[3]; C.w_in = args.in[4]; C.sink = args.in[5]; C.conv_w = args.in[6]; C.conv_b = args.in[7];
    C.fw1 = args.in[8]; C.fb1 = args.in[9]; C.ff1 = args.in[10]; C.fw2 = args.in[11]; C.fb2 = args.in[12]; C.ff2 = args.in[13]; C.fw3 = args.in[14]; C.fdec = args.in[15];
    C.hyd = args.in[16]; C.ang = args.in[17]; C.hng = args.in[18]; C.w_out = args.in[19]; C.lng = args.in[20]; C.lnb = args.in[21];
    C.dout = args.out; C.WIN = (bf16_t*)(ws + WS_WIN); C.WOUT = (bf16_t*)(ws + WS_WOUT); C.HB = (bf16_t*)(ws + WS_HB); C.QKVG = (bf16_t*)(ws + WS_QKVG);
    C.GH = (bf16_t*)(ws + WS_GH); C.HYT = (bf16_t*)(ws + WS_HYT); C.FILT = (bf16_t*)(ws + WS_FILT); C.H2 = (float*)(ws + WS_SMALL); C.NRM = (float*)(ws + WS_NRM); C.ROPE = (float*)(ws + WS_ROPE);
    C.UT0 = C.HB; C.UT1 = C.HB + (size_t)1024 * MTOK; C.ZT = C.HYT; C.A2 = C.HYT + (size_t)1024 * MTOK; C.FP = C.FILT; C.FS = C.FILT + (size_t)1024 * 2 * LP;
    LAS unsigned char* lds3 = (LAS unsigned char*)lds;
    for (int u = C.tid; u < (LDS_BYTES - LDSCTL_OFF) / 4; u += NTHR) ((LAS unsigned*)(lds3 + LDSCTL_OFF))[u] = 0u;
    __syncthreads();
    XcdBarrier bar = xcd_barrier_post((unsigned*)(ws + WS_CTL) + CW_BAR, (volatile LAS unsigned*)(lds3 + MISC_OFF) + 8);
#define GRID_BAR() xcd_barrier(bar)
#define H2P_(l) (C.H2 + (size_t)(l) * (size_t)(5 * MiB / 8))
#define H2S_(l) (C.H2 + (size_t)(l) * (size_t)(5 * MiB / 8) + (size_t)(2 * MiB / 4))

    ph_ln_rows(C, C.x_prompt, C.x_sample, LP, C.emb_g, C.emb_b, C.dout, C.HB);
    ph_rope_table(C);
    ph_transpose(C, C.w_in, C.WIN, DMOD, DIN);
    ph_transpose(C, C.w_out, C.WOUT, DMOD, DMOD);
    for (int l = 0; l < 2; ++l) { ph_filt_h2(C, l, H2P_(l), LP); ph_filt_h2(C, l, H2S_(l), LS); }
    GRID_BAR();
    for (int l = 0; l < 2; ++l) {
        { pg8::Gemm g{C.HB, C.WIN, MTOK, DIN, DMOD}; pg8::StaticOrder S; S.init(MTOK, DIN, C.G, C.bx);
          pg8::EpiIn E{C.QKVG, C.GH, C.HYT};
          pg8::gemm_phase<pg8::EpiIn, pg8::StaticOrder, true, true>(lds3, g, S, E); }
        GRID_BAR();
        ph_attn_naive(C, C.sink + l * 16);
        ph_shortconv_hv(C, C.conv_w + (size_t)l * 3 * 3072, C.conv_b + (size_t)l * 3072);
        ph_filt_taps(C, l, H2P_(l), 0, C.FP, C.NRM, LP); ph_filt_taps(C, l, H2S_(l), 0, C.FS, C.NRM + 1024, LS);
        if (l == 0) ph_transpose(C, C.w_in + (size_t)DMOD * DIN, C.WIN, DMOD, DIN);
        GRID_BAR();
        ph_conv_naive(C, l, 0);
        GRID_BAR();
        ph_filt_taps(C, l, H2P_(l), 1, C.FP, C.NRM, LP); ph_filt_taps(C, l, H2S_(l), 1, C.FS, C.NRM + 1024, LS);
        GRID_BAR();
        ph_conv_naive(C, l, 1);
        GRID_BAR();
        ph_norm_gate(C, l);
        GRID_BAR();
        { pg8::Gemm g{C.A2, C.WOUT, MTOK, DMOD, DMOD}; pg8::StaticOrder S; S.init(MTOK, DMOD, C.G, C.bx);
          pg8::EpiOut E{C.dout};
          pg8::gemm_phase<pg8::EpiOut, pg8::StaticOrder, true, true>(lds3, g, S, E); }
        GRID_BAR();
        ph_ln_rows(C, C.dout, C.dout, MTOK, C.lng + l * DMOD, C.lnb + l * DMOD, C.dout, C.HB);
        if (l == 0) ph_transpose(C, C.w_out + (size_t)DMOD * DMOD, C.WOUT, DMOD, DMOD);
        if (l == 0) GRID_BAR();
    }
}

extern "C" void kernel_launch(void* const* d_in, const int* in_sizes, int n_in, void* d_out, int out_size, void* d_ws, size_t ws_size, hipStream_t stream) {
    static int grid = 0;
    if (grid == 0) {
        if (n_in != 22 || out_size != MTOK * DMOD || ws_size < WS_END) { fprintf(stderr, "kernel_launch: unexpected shapes or workspace (%d inputs, out %d, ws %zu)\n", n_in, out_size, ws_size); grid = -1; return; }
        int dev = 0, cus = 0;
        if (hipGetDevice(&dev) != hipSuccess || hipDeviceGetAttribute(&cus, hipDeviceAttributeMultiprocessorCount, dev) != hipSuccess) { grid = -1; return; }
        if (hipFuncSetAttribute((const void*)fwd_megakernel, hipFuncAttributeMaxDynamicSharedMemorySize, LDS_BYTES) != hipSuccess) { fprintf(stderr, "kernel_launch: hipFuncSetAttribute failed\n"); grid = -1; return; }
        grid = cus;
    }
    if (grid < 0) return;
    if (hipMemsetAsync((char*)d_ws + WS_CTL, 0, CTL_ZERO_BYTES, stream) != hipSuccess) return;
    Args a{};
    for (int i = 0; i < 22; ++i) a.in[i] = (const float*)d_in[i];
    a.out = (float*)d_out; a.ws = (unsigned char*)d_ws;
    hipLaunchKernelGGL(fwd_megakernel, dim3(grid), dim3(NTHR), LDS_BYTES, stream, a);
}
```

```cpp
#include <hip/hip_runtime.h>
#include <cstdio>
#include <cstdint>
namespace pg8 {
#define PG8_LAS __attribute__((address_space(3)))
typedef unsigned short bf16_t;
typedef short bf16x8 __attribute__((ext_vector_type(8)));
typedef float f32x4 __attribute__((ext_vector_type(4)));
typedef unsigned u32x4 __attribute__((ext_vector_type(4)));
constexpr int BM = 256, BK = 64, HALF = 128, HTB = HALF * BK * 2  , STAGE_BYTES = 8 * HTB, NXCD = 8, WGM = 8;

__host__ __device__ __forceinline__ int lds_byte(int r, int c) { const int st = (r >> 4) * 2 + (c >> 5), rr = r & 15, cc = c & 31, ob = rr * 64 + cc * 2; return st * 1024 + (ob ^ (((ob >> 9) & 1) << 5)); }
__host__ __device__ __forceinline__ void stage_rc(int b, int& R, int& C) { const int st = b / 1024, sb = b % 1024, swz = sb ^ (((sb >> 9) & 1) << 5); R = (st >> 1) * 16 + swz / 64; C = (st & 1) * 32 + (swz % 64) / 2; }
__host__ __device__ __forceinline__ int perm32(int rho) { const int n = rho >> 4, i = rho & 15; return 8 * (i >> 2) + 4 * n + (i & 3); }

struct Unit { int pm, pn; };
struct Gemm { const bf16_t* A; const bf16_t* Bt; int M, N, K; };

struct StaticOrder {
    int nM, nN, nwg, G, c;
    __host__ __device__ void init(int M, int N, int G_, int c_) { nM = M / BM; nN = N / BM; nwg = nM * nN; G = G_; c = c_; }
    __host__ __device__ bool next(int i, Unit& u) const {
        const long L = (long)i * G + c; if (L >= nwg) return false;
        int wgid = (int)L; { const int q = nwg / NXCD, r = nwg % NXCD, xcd = wgid % NXCD, off = wgid / NXCD; wgid = (xcd < r ? xcd * (q + 1) : r * (q + 1) + (xcd - r) * q) + off; }
        const int nig = WGM * nN, gid = wgid / nig, fm = gid * WGM, gsz = (nM - fm) < WGM ? (nM - fm) : WGM;
        u.pm = fm + ((wgid % nig) % gsz); u.pn = (wgid % nig) / gsz; return true;
    }
    __device__ __forceinline__ void a_ready(const Unit&) const {}
    __device__ __forceinline__ void done(const Unit&) const {}
};

__device__ __forceinline__ unsigned cvt_pk_bf16(float lo, float hi) { unsigned r; asm volatile("v_cvt_pk_bf16_f32 %0, %1, %2" : "=v"(r) : "v"(lo), "v"(hi)); return r; }
typedef float f32x2 __attribute__((ext_vector_type(2)));
__device__ __forceinline__ f32x2 gelu_pk(f32x2 v) {
    const f32x2 av = __builtin_elementwise_abs(v), d = av * 0.2316418882f + 1.0f;
    f32x2 t; t.x = __builtin_amdgcn_rcpf(d.x); t.y = __builtin_amdgcn_rcpf(d.y);
    f32x2 q = t * 0.5307027145f + (-0.7265760135f); q = q * t + 0.7107068705f; q = q * t + (-0.142248368f); q = q * t + 0.127414796f; q = q * t;
    const f32x2 s = (v * v) * (-0.72134752044f);
    f32x2 e; e.x = __builtin_amdgcn_exp2f(s.x); e.y = __builtin_amdgcn_exp2f(s.y);
    const f32x2 m = v * (q * e), r = v - m;
    f32x2 o; o.x = v.x < 0.f ? m.x : r.x; o.y = v.y < 0.f ? m.y : r.y; return o;
}

template <int ACT  > struct EpiBf16 {
    static constexpr bool PERM = true, AFTER_DRAIN = false; static_assert(ACT == 0 || ACT == 1, "EpiBf16: ACT is 0 (none) or 1 (gelu_pk)");
    bf16_t* O; int ldc; const float* bias; int split_cols; size_t split_stride; float scale0;
    __device__ __forceinline__ void operator()(const f32x4 (&acc)[2][2][4][2], const Unit& u, int wr, int wc, int fr, int fq) const {
        const int row0 = u.pm * BM + wr * 64 + fr; int colt = u.pn * BM; bf16_t* base = O;
        float sc = 1.f; if (split_cols) { const int t = colt / split_cols; base += (size_t)t * split_stride; colt -= t * split_cols; if (t == 0) sc = scale0; }
        const int col0 = colt + wc * 32 + 8 * fq, bcol0 = u.pn * BM + wc * 32 + 8 * fq;
        f32x4 bv[2][2];
#pragma unroll
        for (int bj = 0; bj < 2; ++bj)
#pragma unroll
            for (int n = 0; n < 2; ++n) bv[bj][n] = bias ? *(const f32x4*)(bias + bcol0 + bj * HALF + 4 * n) : (f32x4){0.f, 0.f, 0.f, 0.f};
#pragma unroll
        for (int ai = 0; ai < 2; ++ai)
#pragma unroll
            for (int m = 0; m < 4; ++m) { bf16_t* rowp = base + (size_t)(row0 + ai * HALF + m * 16) * ldc + col0;
#pragma unroll
                for (int bj = 0; bj < 2; ++bj) { f32x4 v0 = acc[ai][bj][m][0] + bv[bj][0], v1 = acc[ai][bj][m][1] + bv[bj][1];
                    if (ACT == 1) { f32x2 a = gelu_pk((f32x2){v0[0], v0[1]}), b = gelu_pk((f32x2){v0[2], v0[3]}), c = gelu_pk((f32x2){v1[0], v1[1]}), d = gelu_pk((f32x2){v1[2], v1[3]});
                        v0 = (f32x4){a.x, a.y, b.x, b.y}; v1 = (f32x4){c.x, c.y, d.x, d.y}; }
                    v0 = v0 * sc; v1 = v1 * sc; u32x4 w; w.x = cvt_pk_bf16(v0[0], v0[1]); w.y = cvt_pk_bf16(v0[2], v0[3]); w.z = cvt_pk_bf16(v1[0], v1[1]); w.w = cvt_pk_bf16(v1[2], v1[3]);
                    *(u32x4*)(rowp + bj * HALF) = w; } }
    }
};

constexpr int MTOK = 24576, LP = 8192, LS = 2048, DMOD = 2048, DIN = 6656;
constexpr int QKVG_W = 2560;
constexpr float DN_ALPHA_F = 1.41421356237f;

__device__ __forceinline__ float silu_f(float x) { return x / (1.0f + __expf(-x)); }

struct EpiIn {
    static constexpr bool PERM = true, AFTER_DRAIN = false;
    bf16_t* qkvg; bf16_t* gh; bf16_t* hyt;
    __device__ __forceinline__ void operator()(const f32x4 (&acc)[2][2][4][2], const Unit& u, int wr, int wc, int fr, int fq) const {
        const int row0 = u.pm * BM + wr * 64 + fr; const int colt = u.pn * BM;
#pragma unroll
        for (int ai = 0; ai < 2; ++ai)
#pragma unroll
            for (int m = 0; m < 4; ++m) { const int row = row0 + ai * HALF + m * 16;
#pragma unroll
                for (int bj = 0; bj < 2; ++bj) { f32x4 v0 = acc[ai][bj][m][0], v1 = acc[ai][bj][m][1];
                    const int c0 = colt + bj * HALF + wc * 32 + 8 * fq;
                    if (colt < 2560) {
                        if (colt >= 1536) { for (int e = 0; e < 4; ++e) { v0[e] = silu_f(v0[e]); v1[e] = silu_f(v1[e]); } }
                        u32x4 w; w.x = cvt_pk_bf16(v0[0], v0[1]); w.y = cvt_pk_bf16(v0[2], v0[3]); w.z = cvt_pk_bf16(v1[0], v1[1]); w.w = cvt_pk_bf16(v1[2], v1[3]);
                        *(u32x4*)(qkvg + (size_t)row * QKVG_W + c0) = w;
                    } else if (colt < 5632) {
                        u32x4 w; w.x = cvt_pk_bf16(v0[0], v0[1]); w.y = cvt_pk_bf16(v0[2], v0[3]); w.z = cvt_pk_bf16(v1[0], v1[1]); w.w = cvt_pk_bf16(v1[2], v1[3]);
                        const int ch = c0 - 2560;
                        bf16_t* p = hyt + (size_t)ch * MTOK + row;
                        p[0] = (bf16_t)(w.x & 0xffff); p[(size_t)MTOK] = (bf16_t)(w.x >> 16); p[(size_t)2 * MTOK] = (bf16_t)(w.y & 0xffff); p[(size_t)3 * MTOK] = (bf16_t)(w.y >> 16);
                        p[(size_t)4 * MTOK] = (bf16_t)(w.z & 0xffff); p[(size_t)5 * MTOK] = (bf16_t)(w.z >> 16); p[(size_t)6 * MTOK] = (bf16_t)(w.w & 0xffff); p[(size_t)7 * MTOK] = (bf16_t)(w.w >> 16);
                    } else {
                        for (int e = 0; e < 4; ++e) { v0[e] = silu_f(v0[e]); v1[e] = silu_f(v1[e]); }
                        u32x4 w; w.x = cvt_pk_bf16(v0[0], v0[1]); w.y = cvt_pk_bf16(v0[2], v0[3]); w.z = cvt_pk_bf16(v1[0], v1[1]); w.w = cvt_pk_bf16(v1[2], v1[3]);
                        *(u32x4*)(gh + (size_t)row * 1024 + (c0 - 5632)) = w;
                    } } }
    }
};
struct EpiOut {
    static constexpr bool PERM = true, AFTER_DRAIN = false;
    float* dout;
    __device__ __forceinline__ void operator()(const f32x4 (&acc)[2][2][4][2], const Unit& u, int wr, int wc, int fr, int fq) const {
        const int row0 = u.pm * BM + wr * 64 + fr; const int colt = u.pn * BM;
#pragma unroll
        for (int ai = 0; ai < 2; ++ai)
#pragma unroll
            for (int m = 0; m < 4; ++m) { const int row = row0 + ai * HALF + m * 16;
#pragma unroll
                for (int bj = 0; bj < 2; ++bj) { const int c0 = colt + bj * HALF + wc * 32 + 8 * fq;
                    float* p = dout + (size_t)row * DMOD + c0;
                    f32x4 r0 = *(const f32x4*)p, r1 = *(const f32x4*)(p + 4);
                    r0 = r0 * DN_ALPHA_F + acc[ai][bj][m][0]; r1 = r1 * DN_ALPHA_F + acc[ai][bj][m][1];
                    *(f32x4*)p = r0; *(f32x4*)(p + 4) = r1; } }
    }
};
template <class Epi, class Sched, bool ALIGN_EPI = false, bool SP2 = false>
__device__ __forceinline__ void gemm_phase(PG8_LAS unsigned char* lds, const Gemm g, const Sched& S, const Epi& E) {
    int tid_o = threadIdx.x; asm volatile("" : "+v"(tid_o));
    const int tid = tid_o, wid = __builtin_amdgcn_readfirstlane(tid >> 6), lane = tid & 63, wr = wid >> 2, wc = wid & 3, fr = lane & 15, fq = lane >> 4;
    const int K = g.K, nt = K / BK;
    unsigned voffA[2], voffB[2];
#pragma unroll
    for (int i = 0; i < 2; ++i) { int R, C; stage_rc(tid * 16 + i * 8192, R, C); const int Rb = Epi::PERM ? ((R & ~31) + perm32(R & 31)) : R;
        voffA[i] = (unsigned)(R * K + C) * 2u; voffB[i] = (unsigned)(Rb * K + C) * 2u; }
    const size_t kstep = (size_t)(BK * 2);
    const size_t hstep = (size_t)HALF * K * 2;
    const size_t tstep = 2 * hstep;
    const unsigned ldsw = (unsigned)wid * 1024u;
    const int aoff = lds_byte(wr * 64 + fr, fq * 8), boff = lds_byte(wc * 32 + fr, fq * 8);
#define PG8_SA(b, h) (((b) * 2 + (h)) * HTB)
#define PG8_SB(b, h) ((4 + (b) * 2 + (h)) * HTB)
#define PG8_STAGE(bufoff, gbase, voff) do { _Pragma("unroll") for (int _i = 0; _i < 2; ++_i) \
        __builtin_amdgcn_global_load_lds((const unsigned*)((const char*)(gbase) + (voff)[_i]), (PG8_LAS unsigned*)(lds + (bufoff) + ldsw + _i * 8192), 16, 0, 0); } while (0)
#define PG8_LDA(dst, b, h) do { _Pragma("unroll") for (int m = 0; m < 4; ++m) _Pragma("unroll") for (int k = 0; k < 2; ++k) dst[m][k] = *(const PG8_LAS bf16x8*)(lds + PG8_SA(b, h) + aoff + m * 2048 + k * 1024); } while (0)
#define PG8_LDB(dst, b, h) do { _Pragma("unroll") for (int n = 0; n < 2; ++n) _Pragma("unroll") for (int k = 0; k < 2; ++k) dst[n][k] = *(const PG8_LAS bf16x8*)(lds + PG8_SB(b, h) + boff + n * 2048 + k * 1024); } while (0)
#define PG8_MMA(ai, bj, At, Bt) do { __builtin_amdgcn_s_setprio(1); _Pragma("unroll") for (int m = 0; m < 4; ++m) _Pragma("unroll") for (int n = 0; n < 2; ++n) _Pragma("unroll") for (int k = 0; k < 2; ++k) \
        acc[ai][bj][m][n] = __builtin_amdgcn_mfma_f32_16x16x32_bf16(Bt[n][k], At[m][k], acc[ai][bj][m][n], 0, 0, 0); __builtin_amdgcn_s_setprio(0); } while (0)
#define PG8_WAIT_V(n) asm volatile("s_waitcnt vmcnt(" #n ")" ::: "memory")
#define PG8_WAIT_L(n) asm volatile("s_waitcnt lgkmcnt(" #n ")" ::: "memory")
#define PG8_BAR __builtin_amdgcn_s_barrier()
#define PG8_SCHED __builtin_amdgcn_sched_barrier(0)
    Unit cur, nxt; int ui = 0;
    if (!S.next(0, cur)) return;
    f32x4 acc[2][2][4][2];
#pragma unroll
    for (int a = 0; a < 2; ++a)
#pragma unroll
        for (int b = 0; b < 2; ++b)
#pragma unroll
            for (int m = 0; m < 4; ++m)
#pragma unroll
                for (int n = 0; n < 2; ++n) acc[a][b][m][n] = (f32x4){0.f, 0.f, 0.f, 0.f};
    bf16x8 At[4][2], B0[2][2], B1[2][2];
    const char* cA = (const char*)g.A + (size_t)cur.pm * tstep; const char* cB = (const char*)g.Bt + (size_t)cur.pn * tstep;
    S.a_ready(cur);
    if constexpr (SP2) {
        PG8_STAGE(PG8_SB(0, 0), cB, voffB); PG8_STAGE(PG8_SB(0, 1), cB + hstep, voffB); PG8_STAGE(PG8_SA(0, 0), cA, voffA); PG8_STAGE(PG8_SA(0, 1), cA + hstep, voffA);
        if (wr == 1) PG8_BAR;
        PG8_WAIT_V(2); PG8_BAR;
        PG8_STAGE(PG8_SB(1, 0), cB + kstep, voffB); PG8_STAGE(PG8_SA(1, 0), cA + kstep, voffA); PG8_STAGE(PG8_SB(1, 1), cB + hstep + kstep, voffB);
        PG8_WAIT_V(6); PG8_BAR;
    } else {
        PG8_STAGE(PG8_SB(0, 0), cB, voffB); PG8_STAGE(PG8_SA(0, 0), cA, voffA); PG8_STAGE(PG8_SB(0, 1), cB + hstep, voffB); PG8_STAGE(PG8_SA(0, 1), cA + hstep, voffA);
        if (wr == 1) PG8_BAR;
        PG8_WAIT_V(4); PG8_BAR;
        PG8_STAGE(PG8_SB(1, 0), cB + kstep, voffB); PG8_STAGE(PG8_SA(1, 0), cA + kstep, voffA); PG8_STAGE(PG8_SB(1, 1), cB + hstep + kstep, voffB);
        PG8_WAIT_V(6); PG8_BAR;
    }
    for (;;) {
        const bool has_next = S.next(ui + 1, nxt);
        const char* nA = has_next ? (const char*)g.A + (size_t)nxt.pm * tstep : cA; const char* nB = has_next ? (const char*)g.Bt + (size_t)nxt.pn * tstep : cB;
        for (int t = 0; t < nt; t += 2) {
            const bool last = (t == nt - 2);
            const char* a1 = cA + (size_t)(t + 1) * kstep;
            const char* a2 = last ? nA : cA + (size_t)(t + 2) * kstep; const char* b2 = last ? nB : cB + (size_t)(t + 2) * kstep;
            const char* a3 = a2 + kstep; const char* b3 = b2 + kstep;
            if (last && has_next) S.a_ready(nxt);
            if constexpr (SP2) {
            PG8_LDB(B0, 0, 0); PG8_LDB(B1, 0, 1); PG8_SCHED; PG8_LDA(At, 0, 0); PG8_STAGE(PG8_SA(1, 1), a1 + hstep, voffA);
            PG8_WAIT_V(8); PG8_WAIT_L(0); PG8_BAR; PG8_MMA(0, 0, At, B0); PG8_MMA(0, 1, At, B1); PG8_BAR; PG8_SCHED;
            PG8_LDA(At, 0, 1); PG8_STAGE(PG8_SB(0, 0), b2, voffB); PG8_STAGE(PG8_SB(0, 1), b2 + hstep, voffB); PG8_STAGE(PG8_SA(0, 0), a2, voffA);
            PG8_WAIT_V(8); PG8_WAIT_L(0); PG8_BAR; PG8_MMA(1, 0, At, B0); PG8_MMA(1, 1, At, B1); PG8_BAR; PG8_SCHED;
            PG8_LDB(B0, 1, 0); PG8_LDB(B1, 1, 1); PG8_SCHED; PG8_LDA(At, 1, 0); PG8_STAGE(PG8_SA(0, 1), a2 + hstep, voffA);
            PG8_WAIT_V(8); PG8_WAIT_L(0); PG8_BAR; PG8_MMA(0, 0, At, B0); PG8_MMA(0, 1, At, B1); PG8_BAR; PG8_SCHED;
            PG8_LDA(At, 1, 1); PG8_STAGE(PG8_SB(1, 0), b3, voffB); PG8_STAGE(PG8_SB(1, 1), b3 + hstep, voffB); PG8_STAGE(PG8_SA(1, 0), a3, voffA);
            PG8_WAIT_V(8); PG8_WAIT_L(0); PG8_BAR; PG8_MMA(1, 0, At, B0); PG8_MMA(1, 1, At, B1); PG8_BAR; PG8_SCHED;
            } else {
            PG8_LDB(B0, 0, 0); PG8_SCHED; PG8_LDA(At, 0, 0); PG8_STAGE(PG8_SA(1, 1), a1 + hstep, voffA);
            PG8_WAIT_L(8); PG8_BAR; PG8_WAIT_L(0); PG8_MMA(0, 0, At, B0); PG8_BAR; PG8_SCHED;
            PG8_LDB(B1, 0, 1); PG8_STAGE(PG8_SB(0, 0), b2, voffB);
            PG8_BAR; PG8_WAIT_L(0); PG8_MMA(0, 1, At, B1); PG8_BAR;
            PG8_LDA(At, 0, 1); PG8_STAGE(PG8_SA(0, 0), a2, voffA);
            PG8_BAR; PG8_WAIT_L(0); PG8_MMA(1, 0, At, B0); PG8_BAR; PG8_SCHED;
            PG8_STAGE(PG8_SB(0, 1), b2 + hstep, voffB);
            PG8_WAIT_V(6); PG8_BAR; PG8_MMA(1, 1, At, B1); PG8_BAR;
            PG8_LDB(B0, 1, 0); PG8_SCHED; PG8_LDA(At, 1, 0); PG8_STAGE(PG8_SA(0, 1), a2 + hstep, voffA);
            PG8_WAIT_L(8); PG8_BAR; PG8_WAIT_L(0); PG8_MMA(0, 0, At, B0); PG8_BAR; PG8_SCHED;
            PG8_LDB(B1, 1, 1); PG8_STAGE(PG8_SB(1, 0), b3, voffB);
            PG8_BAR; PG8_WAIT_L(0); PG8_MMA(0, 1, At, B1); PG8_BAR;
            PG8_LDA(At, 1, 1); PG8_STAGE(PG8_SA(1, 0), a3, voffA);
            PG8_BAR; PG8_WAIT_L(0); PG8_MMA(1, 0, At, B0); PG8_BAR; PG8_SCHED;
            PG8_STAGE(PG8_SB(1, 1), b3 + hstep, voffB);
            PG8_WAIT_V(6); PG8_BAR; PG8_MMA(1, 1, At, B1); PG8_BAR;
            }
        }
        if constexpr (ALIGN_EPI) { if (wr == 0) PG8_BAR; }
        if constexpr (!Epi::AFTER_DRAIN) { E(acc, cur, wr, wc, fr, fq); S.done(cur); }
        if (!has_next) break;
#pragma unroll
        for (int a = 0; a < 2; ++a)
#pragma unroll
            for (int b = 0; b < 2; ++b)
#pragma unroll
                for (int m = 0; m < 4; ++m)
#pragma unroll
                    for (int n = 0; n < 2; ++n) acc[a][b][m][n] = (f32x4){0.f, 0.f, 0.f, 0.f};
        cur = nxt; cA = nA; cB = nB; ++ui;
        if constexpr (ALIGN_EPI) { if (wr == 1) PG8_BAR; }
    }
    PG8_WAIT_V(0);
    if constexpr (!ALIGN_EPI) { if (wr == 0) PG8_BAR; }
    PG8_BAR;
    if constexpr (Epi::AFTER_DRAIN) { E.fused(acc, cur, wr, wc, fr, fq, lds, wid, lane); S.done(cur); }
#undef PG8_SA
#undef PG8_SB
#undef PG8_STAGE
#undef PG8_LDA
#undef PG8_LDB
#undef PG8_MMA
#undef PG8_WAIT_V
#undef PG8_WAIT_L
#undef PG8_BAR
#undef PG8_SCHED
}
}
#define GAS __attribute__((address_space(1)))
#define LAS __attribute__((address_space(3)))
typedef unsigned short bf16;
typedef unsigned v4u __attribute__((ext_vector_type(4)));
typedef float f32x4 __attribute__((ext_vector_type(4)));
typedef short bf16x8 __attribute__((ext_vector_type(8)));
typedef GAS unsigned gu32;
typedef GAS unsigned long long gu64;
#define RLX_AGENT __ATOMIC_RELAXED, __HIP_MEMORY_SCOPE_AGENT
#define LDS_WAIT() asm volatile("s_waitcnt lgkmcnt(0)" ::: "memory")
#define VM_WAIT() asm volatile("s_waitcnt vmcnt(0)" ::: "memory")
__device__ __forceinline__ unsigned long long rt() { return __builtin_amdgcn_s_memrealtime(); }
__device__ __forceinline__ unsigned f2bf(float f) { unsigned u = __builtin_bit_cast(unsigned, f); return (u + 0x7fffu + ((u >> 16) & 1u)) >> 16; }
__device__ __forceinline__ unsigned pk2(float lo, float hi) { return f2bf(lo) | (f2bf(hi) << 16); }

#define XB_TMO      128
#define XB_XCNT(j)  (256  + 64 * (j))
#define XB_XSUB(j)  (1280 + 64 * (j))
#define XB_XGEN(j)  (2304 + 64 * (j))
#define XB_TOP      3328
#define XB_TOPGEN   3392
#define XCD_BAR_WORDS 3456
#define XB_SPIN_CAP (1u << 18)

__device__ __forceinline__ unsigned xb_ld(unsigned* p)              { return __hip_atomic_load(p, __ATOMIC_RELAXED, __HIP_MEMORY_SCOPE_AGENT); }
__device__ __forceinline__ unsigned xb_add(unsigned* p, unsigned v) { return __hip_atomic_fetch_add(p, v, __ATOMIC_RELAXED, __HIP_MEMORY_SCOPE_AGENT); }
__device__ __forceinline__ unsigned xb_xcc_id() { return (unsigned)__builtin_amdgcn_s_getreg((3 << 11) | 20) & 0xFu; }
#define XB_SPIN(cond, bar) do { unsigned _sp = 0; while (cond) { __builtin_amdgcn_s_sleep(1); \
    if ((++_sp & 255u) == 0u) { if (xb_ld(&(bar)[XB_TMO])) break; if (_sp > XB_SPIN_CAP) { atomicAdd(&(bar)[XB_TMO], 1u); break; } } } } while (0)

struct XcdBarrier {
    unsigned* bar; unsigned x;
    volatile LAS unsigned* st;
};

__device__ __forceinline__ XcdBarrier xcd_barrier_post(unsigned* bar, volatile LAS unsigned* st) {
    XcdBarrier b; b.bar = bar; b.x = xb_xcc_id(); b.st = st;
    if (threadIdx.x == 0) (void)xb_add(&bar[XB_XCNT(b.x)], 1u);
    return b;
}
__device__ __forceinline__ void xcd_barrier_complete(unsigned* bar, unsigned x, unsigned& nloc, unsigned& nx) {
    const unsigned G = gridDim.x * gridDim.y * gridDim.z;
    unsigned sum, cnt, mine, sp = 0u;
    for (;;) {
        sum = 0u; cnt = 0u; mine = 0u;
#pragma unroll
        for (unsigned j = 0; j < 16; ++j) { const unsigned c = xb_ld(&bar[XB_XCNT(j)]); sum += c; cnt += (c > 0u) ? 1u : 0u; mine = (j == x) ? c : mine; }
        if (sum == G) break;
        __builtin_amdgcn_s_sleep(1);
        if ((++sp & 255u) == 0u) { if (xb_ld(&bar[XB_TMO])) break; if (sp > XB_SPIN_CAP) { atomicAdd(&bar[XB_TMO], 1u); break; } }
    }
    nloc = mine > 0u ? mine : 1u; nx = cnt > 0u ? cnt : 1u;
}

__device__ __forceinline__ void xcd_barrier(const XcdBarrier& b) {
    asm volatile("s_waitcnt vmcnt(0)" ::: "memory");
    __syncthreads();
    if (threadIdx.x == 0) {
        unsigned* bar = b.bar;
        __builtin_amdgcn_s_waitcnt(0);
        unsigned nloc = b.st[0], nx = b.st[1];
        if (nloc == 0u) { xcd_barrier_complete(bar, b.x, nloc, nx); b.st[0] = nloc; b.st[1] = nx; }
        const unsigned old = xb_add(&bar[XB_XSUB(b.x)], 1u);
        const unsigned gen = old / nloc;
        if (old + 1u == (gen + 1u) * nloc) {
            __builtin_amdgcn_fence(__ATOMIC_RELEASE, "agent");
            asm volatile("s_waitcnt vmcnt(0)" ::: "memory");
            const unsigned og = xb_add(&bar[XB_TOP], 1u);
            const unsigned tg = og / nx;
            if (og + 1u == (tg + 1u) * nx) xb_add(&bar[XB_TOPGEN], 1u);
            else XB_SPIN(xb_ld(&bar[XB_TOPGEN]) == tg, bar);
            __builtin_amdgcn_fence(__ATOMIC_ACQUIRE, "agent");
            xb_add(&bar[XB_XGEN(b.x)], 1u);
            asm volatile("s_waitcnt vmcnt(0)" ::: "memory");
        } else {
            XB_SPIN(xb_ld(&bar[XB_XGEN(b.x)]) == gen, bar);
            __builtin_amdgcn_fence(__ATOMIC_ACQUIRE, "agent");
            asm volatile("s_waitcnt vmcnt(0)" ::: "memory");
        }
    }
    __syncthreads();
}

using pg8::bf16_t; using pg8::MTOK; using pg8::LP; using pg8::LS; using pg8::DMOD; using pg8::DIN; using pg8::QKVG_W;
typedef unsigned u32x4_t __attribute__((ext_vector_type(4)));
typedef float f32x4_t __attribute__((ext_vector_type(4)));
__device__ __forceinline__ float bf2f(unsigned short b) { return __uint_as_float(((unsigned)b) << 16); }

constexpr size_t MiB = 1u << 20;
constexpr size_t WS_CTL = 0, CTL_ZERO_BYTES = 64 * 1024;
constexpr size_t WS_NRM = 512 * 1024;
constexpr size_t WS_WIN = 1 * MiB, WS_WOUT = 27 * MiB, WS_SMALL = 35 * MiB, WS_HB = 40 * MiB, WS_QKVG = 136 * MiB, WS_GH = 256 * MiB, WS_HYT = 304 * MiB, WS_WIN1 = 448 * MiB, WS_WOUT1 = 474 * MiB, WS_ROPE = 488 * MiB, WS_END = 489 * MiB;
constexpr int CW_BAR = 1024;
constexpr int RING_BYTES = 131072, LDSCTL_OFF = 159744, MISC_OFF = LDSCTL_OFF + 320, LDS_BYTES = 163840;
constexpr int NWAVES = 8, NTHR = 512;

struct Args { const float* in[22]; float* out; unsigned char* ws; };

struct Ctx {
    int tid; int G; int bx;
    unsigned char* lds_g;
    const float *x_prompt, *x_sample, *emb_g, *emb_b, *w_in, *sink, *conv_w, *conv_b, *fw1, *fb1, *ff1, *fw2, *fb2, *ff2, *fw3, *fdec, *hyd, *ang, *hng, *w_out, *lng, *lnb;
    float* dout; bf16_t *WIN, *WOUT, *WIN1, *WOUT1, *HB, *QKVG, *GH, *HYT, *UT0, *UT1, *ZT, *A2, *H2B; float *ROPE;
};
__device__ __forceinline__ void seq_of_row(int m, int& start, int& L, int& pos) {
    if (m < LP) { start = 0; L = LP; pos = m; } else { const int r = m - LP; start = LP + (r / LS) * LS; L = LS; pos = r % LS; }
}
#define OPAQUE_TID(t) int t = threadIdx.x; asm volatile("" : "+v"(t))
#define VB_SETUP(BS) OPAQUE_TID(otid_); const int per_ = NTHR / (BS); const int vsub = otid_ / (BS); const int vtid = otid_ % (BS); (void)vsub; (void)vtid; (void)per_
#define VB_FOR(nvb) for (int it_ = C.bx; it_ * per_ < (nvb); it_ += C.G)

__device__ __forceinline__ void ph_transpose(const Ctx& C, const float* W, bf16_t* WT, int K, int N) {
    VB_SETUP(256); float* t = (float*)C.lds_g + vsub * (32 * 33); const int nbx = N / 32, nvb = nbx * (K / 32);
    VB_FOR(nvb) { const int vb = it_ * per_ + vsub; const int n0 = (vb % nbx) * 32, k0 = (vb / nbx) * 32, tx = vtid & 31, ty = vtid >> 5;
        __syncthreads();
        for (int i = 0; i < 4; ++i) t[(ty + 8 * i) * 33 + tx] = W[(size_t)(k0 + ty + 8 * i) * N + n0 + tx];
        __syncthreads();
        for (int i = 0; i < 4; ++i) WT[(size_t)(n0 + ty + 8 * i) * K + k0 + tx] = (bf16_t)f2bf(t[tx * 33 + ty + 8 * i]); }
    __syncthreads();
}
__device__ __forceinline__ void ph_ln_rows(const Ctx& C, const float* in0, const float* in1, int split, const float* g, const float* b, float* outf, bf16_t* outb) {
    VB_SETUP(256); float* red = (float*)C.lds_g + vsub * 8;
    VB_FOR(MTOK) { const int m = it_ * per_ + vsub; const int tid = vtid;
        const float* src = (m < split) ? in0 + (size_t)m * DMOD : in1 + (size_t)(m - split) * DMOD;
        f32x4_t v0 = *(const f32x4_t*)(src + tid * 8), v1 = *(const f32x4_t*)(src + tid * 8 + 4);
        float s = (v0[0] + v0[1]) + (v0[2] + v0[3]) + (v1[0] + v1[1]) + (v1[2] + v1[3]);
        for (int o = 1; o < 64; o <<= 1) s += __shfl_xor(s, o);
        __syncthreads();
        if ((tid & 63) == 0) red[tid >> 6] = s;
        __syncthreads();
        const float mean = (red[0] + red[1] + red[2] + red[3]) * (1.0f / DMOD);
        v0 = v0 - mean; v1 = v1 - mean;
        float q = (v0[0] * v0[0] + v0[1] * v0[1]) + (v0[2] * v0[2] + v0[3] * v0[3]) + (v1[0] * v1[0] + v1[1] * v1[1]) + (v1[2] * v1[2] + v1[3] * v1[3]);
        for (int o = 1; o < 64; o <<= 1) q += __shfl_xor(q, o);
        if ((tid & 63) == 0) red[4 + (tid >> 6)] = q;
        __syncthreads();
        const float rstd = rsqrtf((red[4] + red[5] + red[6] + red[7]) * (1.0f / DMOD) + 1e-5f);
        const f32x4_t g0 = *(const f32x4_t*)(g + tid * 8), g1 = *(const f32x4_t*)(g + tid * 8 + 4), b0 = *(const f32x4_t*)(b + tid * 8), b1 = *(const f32x4_t*)(b + tid * 8 + 4);
        v0 = v0 * rstd * g0 + b0; v1 = v1 * rstd * g1 + b1;
        *(f32x4_t*)(outf + (size_t)m * DMOD + tid * 8) = v0; *(f32x4_t*)(outf + (size_t)m * DMOD + tid * 8 + 4) = v1;
        u32x4_t w; w.x = pk2(v0[0], v0[1]); w.y = pk2(v0[2], v0[3]); w.z = pk2(v1[0], v1[1]); w.w = pk2(v1[2], v1[3]);
        *(u32x4_t*)(outb + (size_t)m * DMOD + tid * 8) = w; }
    __syncthreads();
}
__device__ __forceinline__ void ph_rope_table(const Ctx& C) {
    OPAQUE_TID(otid_);
    for (int idx = C.bx * NTHR + otid_; idx < LP * 8; idx += C.G * NTHR) { const int pos = idx >> 3, i = idx & 7;
        const float inv = powf(500000.0f, -(float)(2 * i) / 16.0f); const float ang = (float)pos * inv;
        C.ROPE[pos * 16 + i] = cosf(ang); C.ROPE[pos * 16 + 8 + i] = sinf(ang); }
}
__device__ __forceinline__ void ph_attn_naive(const Ctx& C, const float* sink) {
    VB_SETUP(128); float* Ks = (float*)C.lds_g + vsub * 8192; float* Vs = Ks + 4096; bf16_t* qkvg = C.QKVG;
    VB_FOR(3072) { const int vb = it_ * per_ + vsub; const int qb = vb >> 4, h = vb & 15, tid = vtid, kv = h >> 2;
        const int m = qb * 128 + tid; int st, L, pos; seq_of_row(m, st, L, pos);
        const int pos0 = pos - tid;
        float q[64], o[64];
        { const bf16_t* qp = qkvg + (size_t)m * QKVG_W + h * 64;
#pragma unroll
          for (int d = 0; d < 64; ++d) { q[d] = bf2f(qp[d]); o[d] = 0.f; }
#pragma unroll
          for (int i = 0; i < 8; ++i) { const float c = C.ROPE[pos * 16 + i], s = C.ROPE[pos * 16 + 8 + i];
              const float t1 = q[i], t2 = q[i + 8]; q[i] = t1 * c - t2 * s; q[i + 8] = t2 * c + t1 * s; }
#pragma unroll
          for (int d = 0; d < 64; ++d) q[d] *= 0.125f; }
        float mx = sink[h], l = 1.0f;
        for (int kt = 0; kt < 6; ++kt) { const int k0 = pos0 - 128 + kt * 64; const bool tv = (k0 >= 0 && k0 < L);
            __syncthreads();
            if (tv) for (int e = tid; e < 64 * 64; e += 128) { const int j = e >> 6, d = e & 63; const size_t r = (size_t)(st + k0 + j) * QKVG_W;
                Ks[j * 64 + d] = bf2f(qkvg[r + 1024 + kv * 64 + d]); Vs[j * 64 + d] = bf2f(qkvg[r + 1280 + kv * 64 + d]); }
            __syncthreads();
            if (tv) for (int e = tid; e < 64 * 8; e += 128) { const int j = e >> 3, i = e & 7; const float c = C.ROPE[(k0 + j) * 16 + i], s = C.ROPE[(k0 + j) * 16 + 8 + i];
                const float t1 = Ks[j * 64 + i], t2 = Ks[j * 64 + i + 8]; Ks[j * 64 + i] = t1 * c - t2 * s; Ks[j * 64 + i + 8] = t2 * c + t1 * s; }
            __syncthreads();
            if (tv) for (int j = 0; j < 64; ++j) { const int dd = k0 + j - pos;
                if (dd >= -128 && dd <= 128) {
                    float s = 0.f;
#pragma unroll
                    for (int d = 0; d < 64; ++d) s += q[d] * Ks[j * 64 + d];
                    const float mn = fmaxf(mx, s); const float a = __expf(mx - mn), p = __expf(s - mn);
                    l = l * a + p;
#pragma unroll
                    for (int d = 0; d < 64; ++d) o[d] = o[d] * a + p * Vs[j * 64 + d];
                    mx = mn; } } }
        const float il = 1.0f / l; bf16_t* op = qkvg + (size_t)m * QKVG_W + h * 64;
#pragma unroll
        for (int d = 0; d < 64; ++d) op[d] = (bf16_t)f2bf(o[d] * il); }
    __syncthreads();
}
__device__ __forceinline__ void ph_filt_h2(const Ctx& C, int l, bf16_t* H2, int L) {
    VB_SETUP(64); float* z = (float*)C.lds_g + vsub * 128; float* h1 = z + 40;
    const float* w1 = C.fw1 + l * 33 * 64; const float* b1 = C.fb1 + l * 64; const float* f1 = C.ff1 + l * 64; const float* w2 = C.fw2 + l * 64 * 64; const float* b2 = C.fb2 + l * 64; const float* f2 = C.ff2 + l * 64;
    VB_FOR(L) { const int pos = it_ * per_ + vsub, j = vtid;
        __syncthreads();
        if (j < 33) { float v;
            if (j == 0) v = (float)pos / (float)(L - 1);
            else { const int k = (j - 1) & 15; const float band = 1e-4f + (float)k * ((15.0f - 1e-4f) / 15.0f);
                   const float w = 6.283185307179586f * (float)pos / (float)L; const float ang = w * band;
                   v = (j <= 16) ? cosf(ang) : -sinf(ang); }
            z[j] = v; }
        __syncthreads();
        float a = b1[j]; for (int i = 0; i < 33; ++i) a += z[i] * w1[i * 64 + j];
        h1[j] = sinf(f1[j] * a);
        __syncthreads();
        float c = b2[j]; for (int i = 0; i < 64; ++i) c += h1[i] * w2[i * 64 + j];
        H2[pos * 64 + j] = (bf16_t)f2bf(sinf(f2[j] * c)); }
    __syncthreads();
}
__device__ __forceinline__ void ph_norm_gate(const Ctx& C, int l) {
    VB_SETUP(256); float* red = (float*)C.lds_g + vsub * 8; const float* ag = C.ang + l * 1024; const float* hg = C.hng + l * 1024;
    VB_FOR(MTOK) { const int m = it_ * per_ + vsub, tid = vtid;
        float a[4], z[4]; float sa = 0.f, sz = 0.f;
        for (int i = 0; i < 4; ++i) { const int j = tid + 256 * i; a[i] = bf2f(C.QKVG[(size_t)m * QKVG_W + j]); z[i] = bf2f(C.ZT[(size_t)j * MTOK + m]); sa += a[i] * a[i]; sz += z[i] * z[i]; }
        for (int o = 1; o < 64; o <<= 1) { sa += __shfl_xor(sa, o); sz += __shfl_xor(sz, o); }
        __syncthreads();
        if ((tid & 63) == 0) { red[tid >> 6] = sa; red[4 + (tid >> 6)] = sz; }
        __syncthreads();
        const float ra = rsqrtf((red[0] + red[1] + red[2] + red[3]) * (1.0f / 1024.0f) + 1e-5f), rz = rsqrtf((red[4] + red[5] + red[6] + red[7]) * (1.0f / 1024.0f) + 1e-5f);
        for (int i = 0; i < 4; ++i) { const int j = tid + 256 * i;
            C.A2[(size_t)m * DMOD + j] = (bf16_t)f2bf(a[i] * ra * ag[j] * bf2f(C.QKVG[(size_t)m * QKVG_W + 1536 + j]));
            C.A2[(size_t)m * DMOD + 1024 + j] = (bf16_t)f2bf(z[i] * rz * hg[j] * bf2f(C.GH[(size_t)m * 1024 + j])); } }
    __syncthreads();
}


typedef short cj_bf16x8 __attribute__((ext_vector_type(8)));
typedef float cj_f32x4 __attribute__((ext_vector_type(4)));
typedef unsigned cj_u32x2 __attribute__((ext_vector_type(2)));

template <int NB16, int NSQ, int NPASS>
__device__ __forceinline__ void conv_job(const Ctx& C, int l, int grp, LAS unsigned char* lds3, const bf16_t* H2B, int seq_base0) {
    constexpr int L = NB16 * 512, NB = NB16 * 16, RLEN = 2 * L + 128, RC = L + 32, RBYTES = RLEN * 2;
    constexpr int NRM_OFF = 4 * RBYTES;
    static_assert(NRM_OFF + 8 * 8 * 4 + 16 <= LDSCTL_OFF, "conv job LDS");
    OPAQUE_TID(tid);
    const int lane = tid & 63, wid = __builtin_amdgcn_readfirstlane(tid >> 6), cc = wid & 3, mi = wid >> 2;
    const int r16 = lane & 15, g4 = lane >> 4;
    const int c0 = grp * 4, c = c0 + cc;
    const float* cw = C.conv_w + (size_t)l * 3 * 3072; const float* cb = C.conv_b + (size_t)l * 3072;
    LAS float* part = (LAS float*)(lds3 + NRM_OFF); LAS float* nrmv = part + 64;

    { constexpr int CH = NSQ * NPASS * L / 8;
      for (int idx = tid; idx < 4 * CH; idx += NTHR) { const int ch = idx / CH, q = idx % CH; const int cidx_ = c0 + ch;
          const int sq = q / (L / 8), t = (q % (L / 8)) * 8; const size_t off = (size_t)cidx_ * MTOK + seq_base0 + sq * L + t;
          const u32x4_t w = *(const u32x4_t*)(C.HYT + off);
          float h[10]; h[0] = t > 0 ? bf2f(C.HYT[off - 1]) : 0.f; h[9] = t + 8 < L ? bf2f(C.HYT[off + 8]) : 0.f;
#pragma unroll
          for (int e = 0; e < 4; ++e) { h[1 + 2 * e] = __uint_as_float(w[e] << 16); h[2 + 2 * e] = __uint_as_float(w[e] & 0xffff0000u); }
          const float w0 = cw[cidx_], w1 = cw[3072 + cidx_], w2 = cw[6144 + cidx_], bb = cb[cidx_];
          float o[8];
#pragma unroll
          for (int e = 0; e < 8; ++e) o[e] = h[e] * w0 + h[e + 1] * w1 + h[e + 2] * w2 + bb;
          u32x4_t ow; ow.x = pk2(o[0], o[1]); ow.y = pk2(o[2], o[3]); ow.z = pk2(o[4], o[5]); ow.w = pk2(o[6], o[7]);
          *(u32x4_t*)(C.UT0 + off) = ow; } }

#pragma unroll 1
    for (int order = 0; order < 2; ++order) {
        __syncthreads();
        {
          for (int idx = tid; idx < 4 * (33 + 96); idx += NTHR) { const int ch = idx / 129, q = idx % 129; const int x = q < 33 ? q : (2 * L + 32 + (q - 33));
              *(LAS unsigned short*)(lds3 + ch * RBYTES + 2 * x) = 0; }
          const float* w3 = C.fw3 + (size_t)l * 64 * 4096; const float* decay = C.fdec + (size_t)l * 4096;
          const int col = r16; const bool cv = col < 8; const int dir = (col >> 2) & 1, fch = col & 3;
          const int fidx = order * 2048 + dir * 1024 + c0 + fch;
          cj_bf16x8 Bw[2];
#pragma unroll
          for (int ks = 0; ks < 2; ++ks) { unsigned wv[4];
#pragma unroll
              for (int j = 0; j < 4; ++j) { const int k = 32 * ks + 8 * g4 + 2 * j; const float a = cv ? w3[(size_t)k * 4096 + fidx] : 0.f, b = cv ? w3[(size_t)(k + 1) * 4096 + fidx] : 0.f; wv[j] = pk2(a, b); }
              Bw[ks] = __builtin_bit_cast(cj_bf16x8, (u32x4_t){wv[0], wv[1], wv[2], wv[3]}); }
          const float kd = cv ? fabsf(decay[fidx]) * (1.4426950408889634f / (float)(L - 1)) : 0.f;
          float nacc = 0.f;
          LAS unsigned char* Rw = lds3 + fch * RBYTES;
          for (int mt = wid; mt < L / 16; mt += NWAVES) { const int p0 = mt * 16;
              const cj_bf16x8 A0 = *(const cj_bf16x8*)(H2B + (size_t)(p0 + r16) * 64 + 8 * g4), A1 = *(const cj_bf16x8*)(H2B + (size_t)(p0 + r16) * 64 + 32 + 8 * g4);
              cj_f32x4 d = {0.f, 0.f, 0.f, 0.f};
              d = __builtin_amdgcn_mfma_f32_16x16x32_bf16(A0, Bw[0], d, 0, 0, 0);
              d = __builtin_amdgcn_mfma_f32_16x16x32_bf16(A1, Bw[1], d, 0, 0, 0);
#pragma unroll
              for (int rg = 0; rg < 4; ++rg) { const int pos = p0 + 4 * g4 + rg; const float v = d[rg] * __builtin_amdgcn_exp2f(-(float)pos * kd);
                  nacc += fabsf(v);
                  const int x = dir ? RC + pos : RC - pos;
                  if (cv && !(dir && pos == 0)) *(LAS unsigned short*)(Rw + 2 * x) = (unsigned short)f2bf(v); } }
          nacc += __shfl_xor(nacc, 16); nacc += __shfl_xor(nacc, 32);
          if (lane < 8) { LAS float* pw = part + wid * 8 + lane; asm volatile("" : "+v"(pw)); pw[0] = nacc; } }
        asm volatile("s_waitcnt vmcnt(0) lgkmcnt(0)" ::: "memory");
        __syncthreads();
        if (tid < 4) { LAS float* pb = part + tid; asm volatile("" : "+v"(pb)); float s = 0.f; for (int w = 0; w < 8; ++w) s += pb[w * 8] + pb[w * 8 + 4]; pb[64] = s; }
        __syncthreads();
        float inv_n; { LAS float* pn = nrmv + cc; asm volatile("" : "+v"(pn)); inv_n = 1.0f / pn[0]; }
        const float dd = C.hyd[(size_t)l * 2048 + order * 1024 + c];
        const bf16_t* U = (order == 0 ? C.UT0 : C.UT1) + (size_t)c * MTOK;
        bf16_t* Zo = (order == 0 ? C.UT1 : C.ZT) + (size_t)c * MTOK;
        const int gc = 1024 * (order + 1) + c; const bf16_t* HG = C.HYT + (size_t)gc * MTOK;
        const float gw0 = cw[gc], gw1 = cw[3072 + gc], gw2 = cw[6144 + gc], gbb = cb[gc];
        const int xb = RC - 16 * mi - r16 + 8 * g4; const int par = xb & 1; const unsigned sh = (unsigned)par * 16u;
        const unsigned abase0 = (unsigned)(cc * RBYTES + 2 * (xb - par) - (NB16 - 1) * 1024);

#pragma unroll 1
        for (int pass = 0; pass < NPASS; ++pass) {
            const int sbase = seq_base0 + pass * NSQ * L;
            cj_f32x4 acc[NSQ][NB16];
#pragma unroll
            for (int sq = 0; sq < NSQ; ++sq)
#pragma unroll
                for (int n = 0; n < NB16; ++n) acc[sq][n] = (cj_f32x4){0.f, 0.f, 0.f, 0.f};
#pragma unroll 1
            for (int ff = 0; ff < 16; ++ff) { const int f = (ff + 8 * mi) & 15;
                cj_bf16x8 Bf[NSQ][NB16 + 1];
                const bf16_t* ub = U + sbase + 8 * g4 + 32 * (r16 - f);
#pragma unroll
                for (int sq = 0; sq < NSQ; ++sq)
#pragma unroll
                    for (int mp = 0; mp <= NB16; ++mp) { const int ab = 16 * mp + r16 - f;
                        if (mp == 0) { const bool ok = ab >= 0; cj_bf16x8 v = *(const cj_bf16x8*)(ub + sq * L + (ok ? 0 : 32 * f - 32 * r16)); if (!ok) v = (cj_bf16x8){0, 0, 0, 0, 0, 0, 0, 0}; Bf[sq][mp] = v; }
                        else if (mp == NB16) { const bool ok = ab < NB; cj_bf16x8 v = *(const cj_bf16x8*)(ub + sq * L + (ok ? 512 * NB16 : 0)); if (!ok) v = (cj_bf16x8){0, 0, 0, 0, 0, 0, 0, 0}; Bf[sq][mp] = v; }
                        else Bf[sq][mp] = *(const cj_bf16x8*)(ub + sq * L + 512 * mp); }
                const LAS unsigned* ap = (const LAS unsigned*)(lds3 + (abase0 - 64u * (unsigned)f));
                asm volatile("" : "+v"(ap));
                unsigned raw[2][5];
                { raw[0][0] = ap[0]; raw[0][1] = ap[1]; raw[0][2] = ap[2]; raw[0][3] = ap[3]; raw[0][4] = ap[4]; }
#pragma unroll
                for (int ei = 0; ei < 2 * NB16; ++ei) { const int e = NB16 - 1 - ei; const int cb_ = ei & 1, nb_ = cb_ ^ 1;
                    if (ei + 1 < 2 * NB16) { ap += 256; asm volatile("" : "+v"(ap)); raw[nb_][0] = ap[0]; raw[nb_][1] = ap[1]; raw[nb_][2] = ap[2]; raw[nb_][3] = ap[3]; raw[nb_][4] = ap[4]; }
                    u32x4_t aw; aw.x = __builtin_amdgcn_alignbit(raw[cb_][1], raw[cb_][0], sh); aw.y = __builtin_amdgcn_alignbit(raw[cb_][2], raw[cb_][1], sh);
                    aw.z = __builtin_amdgcn_alignbit(raw[cb_][3], raw[cb_][2], sh); aw.w = __builtin_amdgcn_alignbit(raw[cb_][4], raw[cb_][3], sh);
                    const cj_bf16x8 A = __builtin_bit_cast(cj_bf16x8, aw);
#pragma unroll
                    for (int sq = 0; sq < NSQ; ++sq)
#pragma unroll
                        for (int n = 0; n < NB16; ++n) { const int mp = n - e; if (mp >= 0 && mp <= NB16) acc[sq][n] = __builtin_amdgcn_mfma_f32_16x16x32_bf16(A, Bf[sq][mp], acc[sq][n], 0, 0, 0); }
                    __builtin_amdgcn_sched_barrier(0); }
            }
#pragma unroll
            for (int sq = 0; sq < NSQ; ++sq)
#pragma unroll
                for (int n = 0; n < NB16; ++n) { const int t0 = 32 * (16 * n + r16) + 16 * mi + 4 * g4; const size_t off = (size_t)sbase + sq * L + t0;
                    const cj_u32x2 uw = *(const cj_u32x2*)(U + off); const cj_u32x2 hw = *(const cj_u32x2*)(HG + off);
                    float h[6]; h[0] = (n > 0 || t0 > 0) ? bf2f(HG[off - 1]) : 0.f; h[5] = (n < NB16 - 1 || t0 + 4 < L) ? bf2f(HG[off + 4]) : 0.f;
                    h[1] = __uint_as_float(hw.x << 16); h[2] = __uint_as_float(hw.x & 0xffff0000u); h[3] = __uint_as_float(hw.y << 16); h[4] = __uint_as_float(hw.y & 0xffff0000u);
                    float uu[4] = {__uint_as_float(uw.x << 16), __uint_as_float(uw.x & 0xffff0000u), __uint_as_float(uw.y << 16), __uint_as_float(uw.y & 0xffff0000u)};
                    float z[4];
#pragma unroll
                    for (int j = 0; j < 4; ++j) { const float gate = h[j] * gw0 + h[j + 1] * gw1 + h[j + 2] * gw2 + gbb; z[j] = gate * (acc[sq][n][j] * inv_n + dd * uu[j]); }
                    cj_u32x2 ow; ow.x = pk2(z[0], z[1]); ow.y = pk2(z[2], z[3]);
                    *(cj_u32x2*)(Zo + off) = ow; __builtin_amdgcn_sched_barrier(0); }
        }
        asm volatile("s_waitcnt vmcnt(0)" ::: "memory");
    }
    __syncthreads();
}
__global__ void __launch_bounds__(NTHR, 2) fwd_megakernel(Args args) {
    extern __shared__ __attribute__((aligned(16))) unsigned char lds[];
    Ctx C; C.tid = threadIdx.x; C.G = gridDim.x; C.bx = blockIdx.x; C.lds_g = lds;
    unsigned char* ws = args.ws;
    C.x_prompt = args.in[0]; C.x_sample = args.in[1]; C.emb_g = args.in[2]; C.emb_b = args.in[3]; C.w_in = args.in[4]; C.sink = args.in[5]; C.conv_w = args.in[6]; C.conv_b = args.in[7];
    C.fw1 = args.in[8]; C.fb1 = args.in[9]; C.ff1 = args.in[10]; C.fw2 = args.in[11]; C.fb2 = args.in[12]; C.ff2 = args.in[13]; C.fw3 = args.in[14]; C.fdec = args.in[15];
    C.hyd = args.in[16]; C.ang = args.in[17]; C.hng = args.in[18]; C.w_out = args.in[19]; C.lng = args.in[20]; C.lnb = args.in[21];
    C.dout = args.out; C.WIN = (bf16_t*)(ws + WS_WIN); C.WOUT = (bf16_t*)(ws + WS_WOUT); C.HB = (bf16_t*)(ws + WS_HB); C.QKVG = (bf16_t*)(ws + WS_QKVG);
    C.GH = (bf16_t*)(ws + WS_GH); C.HYT = (bf16_t*)(ws + WS_HYT); C.H2B = (bf16_t*)(ws + WS_SMALL); C.ROPE = (float*)(ws + WS_ROPE); C.WIN1 = (bf16_t*)(ws + WS_WIN1); C.WOUT1 = (bf16_t*)(ws + WS_WOUT1);
    C.UT0 = C.HB; C.UT1 = C.HB + (size_t)1024 * MTOK; C.ZT = C.HYT; C.A2 = C.HYT + (size_t)1024 * MTOK;
    LAS unsigned char* lds3 = (LAS unsigned char*)lds;
    for (int u = C.tid; u < (LDS_BYTES - LDSCTL_OFF) / 4; u += NTHR) ((LAS unsigned*)(lds3 + LDSCTL_OFF))[u] = 0u;
    __syncthreads();
    (void)xcd_barrier_post((unsigned*)(ws + WS_CTL) + CW_BAR, (volatile LAS unsigned*)(lds3 + MISC_OFF) + 8);
#define GRID_BAR() do { XcdBarrier bb_; bb_.bar = (unsigned*)(args.ws + WS_CTL) + CW_BAR; bb_.x = xb_xcc_id(); bb_.st = (volatile LAS unsigned*)(lds3 + MISC_OFF) + 8; xcd_barrier(bb_); } while (0)
#define H2P_(l) (C.H2B + (size_t)(l) * (size_t)(655360))
#define H2S_(l) (C.H2B + (size_t)(l) * (size_t)(655360) + (size_t)(524288))

    ph_ln_rows(C, C.x_prompt, C.x_sample, LP, C.emb_g, C.emb_b, C.dout, C.HB);
    ph_rope_table(C);
    ph_transpose(C, C.w_in, C.WIN, DMOD, DIN);
    ph_transpose(C, C.w_out, C.WOUT, DMOD, DMOD);
    ph_transpose(C, C.w_in + (size_t)DMOD * DIN, C.WIN1, DMOD, DIN);
    ph_transpose(C, C.w_out + (size_t)DMOD * DMOD, C.WOUT1, DMOD, DMOD);
    for (int l = 0; l < 2; ++l) { ph_filt_h2(C, l, H2P_(l), LP); ph_filt_h2(C, l, H2S_(l), LS); }
    GRID_BAR();
#pragma unroll 1
    for (int l = 0; l < 2; ++l) {
        { pg8::Gemm g{C.HB, l == 0 ? C.WIN : C.WIN1, MTOK, DIN, DMOD}; pg8::StaticOrder S; S.init(MTOK, DIN, C.G, C.bx);
          pg8::EpiIn E{C.QKVG, C.GH, C.HYT};
          pg8::gemm_phase<pg8::EpiIn, pg8::StaticOrder, true, true>(lds3, g, S, E); }
        GRID_BAR();
        for (int grp = C.bx; grp < 256; grp += C.G) conv_job<16, 1, 1>(C, l, grp, lds3, H2P_(l), 0);
        for (int grp = C.bx; grp < 256; grp += C.G) conv_job<4, 4, 2>(C, l, grp, lds3, H2S_(l), LP);
        ph_attn_naive(C, C.sink + l * 16);
        GRID_BAR();
        ph_norm_gate(C, l);
        GRID_BAR();
        { pg8::Gemm g{C.A2, l == 0 ? C.WOUT : C.WOUT1, MTOK, DMOD, DMOD}; pg8::StaticOrder S; S.init(MTOK, DMOD, C.G, C.bx);
          pg8::EpiOut E{C.dout};
          pg8::gemm_phase<pg8::EpiOut, pg8::StaticOrder, true, true>(lds3, g, S, E); }
        GRID_BAR();
        ph_ln_rows(C, C.dout, C.dout, MTOK, C.lng + l * DMOD, C.lnb + l * DMOD, C.dout, C.HB);
        if (l == 0) GRID_BAR();
    }
}

extern "C" void kernel_launch(void* const* d_in, const int* in_sizes, int n_in, void* d_out, int out_size, void* d_ws, size_t ws_size, hipStream_t stream) {
    static int grid = 0;
    if (grid == 0) {
        if (n_in != 22 || out_size != MTOK * DMOD || ws_size < WS_END) { fprintf(stderr, "kernel_launch: unexpected shapes or workspace (%d inputs, out %d, ws %zu)\n", n_in, out_size, ws_size); grid = -1; return; }
        int dev = 0, cus = 0;
        if (hipGetDevice(&dev) != hipSuccess || hipDeviceGetAttribute(&cus, hipDeviceAttributeMultiprocessorCount, dev) != hipSuccess) { grid = -1; return; }
        if (hipFuncSetAttribute((const void*)fwd_megakernel, hipFuncAttributeMaxDynamicSharedMemorySize, LDS_BYTES) != hipSuccess) { fprintf(stderr, "kernel_launch: hipFuncSetAttribute failed\n"); grid = -1; return; }
        grid = cus;
    }
    if (grid < 0) return;
    if (hipMemsetAsync((char*)d_ws + WS_CTL, 0, CTL_ZERO_BYTES, stream) != hipSuccess) return;
    Args a{};
    for (int i = 0; i < 22; ++i) a.in[i] = (const float*)d_in[i];
    a.out = (float*)d_out; a.ws = (unsigned char*)d_ws;
    hipLaunchKernelGGL(fwd_megakernel, dim3(grid), dim3(NTHR), LDS_BYTES, stream, a);
}
```

```cpp
#include <hip/hip_runtime.h>
#include <cstdio>
#include <cstdint>
namespace pg8 {
#define PG8_LAS __attribute__((address_space(3)))
typedef unsigned short bf16_t;
typedef short bf16x8 __attribute__((ext_vector_type(8)));
typedef float f32x4 __attribute__((ext_vector_type(4)));
typedef unsigned u32x4 __attribute__((ext_vector_type(4)));
constexpr int BM = 256, BK = 64, HALF = 128, HTB = HALF * BK * 2  , STAGE_BYTES = 8 * HTB, NXCD = 8, WGM = 8;

__host__ __device__ __forceinline__ int lds_byte(int r, int c) { const int st = (r >> 4) * 2 + (c >> 5), rr = r & 15, cc = c & 31, ob = rr * 64 + cc * 2; return st * 1024 + (ob ^ (((ob >> 9) & 1) << 5)); }
__host__ __device__ __forceinline__ void stage_rc(int b, int& R, int& C) { const int st = b / 1024, sb = b % 1024, swz = sb ^ (((sb >> 9) & 1) << 5); R = (st >> 1) * 16 + swz / 64; C = (st & 1) * 32 + (swz % 64) / 2; }
__host__ __device__ __forceinline__ int perm32(int rho) { const int n = rho >> 4, i = rho & 15; return 8 * (i >> 2) + 4 * n + (i & 3); }

struct Unit { int pm, pn; };
struct Gemm { const bf16_t* A; const bf16_t* Bt; int M, N, K; };

struct StaticOrder {
    int nM, nN, nwg, G, c;
    __host__ __device__ void init(int M, int N, int G_, int c_) { nM = M / BM; nN = N / BM; nwg = nM * nN; G = G_; c = c_; }
    __host__ __device__ bool next(int i, Unit& u) const {
        const long L = (long)i * G + c; if (L >= nwg) return false;
        int wgid = (int)L; { const int q = nwg / NXCD, r = nwg % NXCD, xcd = wgid % NXCD, off = wgid / NXCD; wgid = (xcd < r ? xcd * (q + 1) : r * (q + 1) + (xcd - r) * q) + off; }
        const int nig = WGM * nN, gid = wgid / nig, fm = gid * WGM, gsz = (nM - fm) < WGM ? (nM - fm) : WGM;
        u.pm = fm + ((wgid % nig) % gsz); u.pn = (wgid % nig) / gsz; return true;
    }
    __device__ __forceinline__ void a_ready(const Unit&) const {}
    __device__ __forceinline__ void done(const Unit&) const {}
};

__device__ __forceinline__ unsigned cvt_pk_bf16(float lo, float hi) { unsigned r; asm volatile("v_cvt_pk_bf16_f32 %0, %1, %2" : "=v"(r) : "v"(lo), "v"(hi)); return r; }
typedef float f32x2 __attribute__((ext_vector_type(2)));
__device__ __forceinline__ f32x2 gelu_pk(f32x2 v) {
    const f32x2 av = __builtin_elementwise_abs(v), d = av * 0.2316418882f + 1.0f;
    f32x2 t; t.x = __builtin_amdgcn_rcpf(d.x); t.y = __builtin_amdgcn_rcpf(d.y);
    f32x2 q = t * 0.5307027145f + (-0.7265760135f); q = q * t + 0.7107068705f; q = q * t + (-0.142248368f); q = q * t + 0.127414796f; q = q * t;
    const f32x2 s = (v * v) * (-0.72134752044f);
    f32x2 e; e.x = __builtin_amdgcn_exp2f(s.x); e.y = __builtin_amdgcn_exp2f(s.y);
    const f32x2 m = v * (q * e), r = v - m;
    f32x2 o; o.x = v.x < 0.f ? m.x : r.x; o.y = v.y < 0.f ? m.y : r.y; return o;
}

template <int ACT  > struct EpiBf16 {
    static constexpr bool PERM = true, AFTER_DRAIN = false; static_assert(ACT == 0 || ACT == 1, "EpiBf16: ACT is 0 (none) or 1 (gelu_pk)");
    bf16_t* O; int ldc; const float* bias; int split_cols; size_t split_stride; float scale0;
    __device__ __forceinline__ void operator()(const f32x4 (&acc)[2][2][4][2], const Unit& u, int wr, int wc, int fr, int fq) const {
        const int row0 = u.pm * BM + wr * 64 + fr; int colt = u.pn * BM; bf16_t* base = O;
        float sc = 1.f; if (split_cols) { const int t = colt / split_cols; base += (size_t)t * split_stride; colt -= t * split_cols; if (t == 0) sc = scale0; }
        const int col0 = colt + wc * 32 + 8 * fq, bcol0 = u.pn * BM + wc * 32 + 8 * fq;
        f32x4 bv[2][2];
#pragma unroll
        for (int bj = 0; bj < 2; ++bj)
#pragma unroll
            for (int n = 0; n < 2; ++n) bv[bj][n] = bias ? *(const f32x4*)(bias + bcol0 + bj * HALF + 4 * n) : (f32x4){0.f, 0.f, 0.f, 0.f};
#pragma unroll
        for (int ai = 0; ai < 2; ++ai)
#pragma unroll
            for (int m = 0; m < 4; ++m) { bf16_t* rowp = base + (size_t)(row0 + ai * HALF + m * 16) * ldc + col0;
#pragma unroll
                for (int bj = 0; bj < 2; ++bj) { f32x4 v0 = acc[ai][bj][m][0] + bv[bj][0], v1 = acc[ai][bj][m][1] + bv[bj][1];
                    if (ACT == 1) { f32x2 a = gelu_pk((f32x2){v0[0], v0[1]}), b = gelu_pk((f32x2){v0[2], v0[3]}), c = gelu_pk((f32x2){v1[0], v1[1]}), d = gelu_pk((f32x2){v1[2], v1[3]});
                        v0 = (f32x4){a.x, a.y, b.x, b.y}; v1 = (f32x4){c.x, c.y, d.x, d.y}; }
                    v0 = v0 * sc; v1 = v1 * sc; u32x4 w; w.x = cvt_pk_bf16(v0[0], v0[1]); w.y = cvt_pk_bf16(v0[2], v0[3]); w.z = cvt_pk_bf16(v1[0], v1[1]); w.w = cvt_pk_bf16(v1[2], v1[3]);
                    *(u32x4*)(rowp + bj * HALF) = w; } }
    }
};

constexpr int MTOK = 24576, LP = 8192, LS = 2048, DMOD = 2048, DIN = 6656;
constexpr int QKVG_W = 2560;
constexpr float DN_ALPHA_F = 1.41421356237f;

__device__ __forceinline__ float silu_f(float x) { return x / (1.0f + __expf(-x)); }

struct EpiIn {
    static constexpr bool PERM = true, AFTER_DRAIN = false;
    bf16_t* qkvg; bf16_t* gh; bf16_t* hyt;
    __device__ __forceinline__ void operator()(const f32x4 (&acc)[2][2][4][2], const Unit& u, int wr, int wc, int fr, int fq) const {
        const int row0 = u.pm * BM + wr * 64 + fr; const int colt = u.pn * BM;
#pragma unroll
        for (int ai = 0; ai < 2; ++ai)
#pragma unroll
            for (int m = 0; m < 4; ++m) { const int row = row0 + ai * HALF + m * 16;
#pragma unroll
                for (int bj = 0; bj < 2; ++bj) { f32x4 v0 = acc[ai][bj][m][0], v1 = acc[ai][bj][m][1];
                    const int c0 = colt + bj * HALF + wc * 32 + 8 * fq;
                    if (colt < 2560) {
                        if (colt >= 1536) { for (int e = 0; e < 4; ++e) { v0[e] = silu_f(v0[e]); v1[e] = silu_f(v1[e]); } }
                        u32x4 w; w.x = cvt_pk_bf16(v0[0], v0[1]); w.y = cvt_pk_bf16(v0[2], v0[3]); w.z = cvt_pk_bf16(v1[0], v1[1]); w.w = cvt_pk_bf16(v1[2], v1[3]);
                        *(u32x4*)(qkvg + (size_t)row * QKVG_W + c0) = w;
                    } else if (colt < 5632) {
                        u32x4 w; w.x = cvt_pk_bf16(v0[0], v0[1]); w.y = cvt_pk_bf16(v0[2], v0[3]); w.z = cvt_pk_bf16(v1[0], v1[1]); w.w = cvt_pk_bf16(v1[2], v1[3]);
                        const int ch = c0 - 2560;
                        bf16_t* p = hyt + (size_t)ch * MTOK + row;
                        p[0] = (bf16_t)(w.x & 0xffff); p[(size_t)MTOK] = (bf16_t)(w.x >> 16); p[(size_t)2 * MTOK] = (bf16_t)(w.y & 0xffff); p[(size_t)3 * MTOK] = (bf16_t)(w.y >> 16);
                        p[(size_t)4 * MTOK] = (bf16_t)(w.z & 0xffff); p[(size_t)5 * MTOK] = (bf16_t)(w.z >> 16); p[(size_t)6 * MTOK] = (bf16_t)(w.w & 0xffff); p[(size_t)7 * MTOK] = (bf16_t)(w.w >> 16);
                    } else {
                        for (int e = 0; e < 4; ++e) { v0[e] = silu_f(v0[e]); v1[e] = silu_f(v1[e]); }
                        u32x4 w; w.x = cvt_pk_bf16(v0[0], v0[1]); w.y = cvt_pk_bf16(v0[2], v0[3]); w.z = cvt_pk_bf16(v1[0], v1[1]); w.w = cvt_pk_bf16(v1[2], v1[3]);
                        *(u32x4*)(gh + (size_t)row * 1024 + (c0 - 5632)) = w;
                    } } }
    }
};
struct EpiOut {
    static constexpr bool PERM = true, AFTER_DRAIN = false;
    float* dout;
    __device__ __forceinline__ void operator()(const f32x4 (&acc)[2][2][4][2], const Unit& u, int wr, int wc, int fr, int fq) const {
        const int row0 = u.pm * BM + wr * 64 + fr; const int colt = u.pn * BM;
#pragma unroll
        for (int ai = 0; ai < 2; ++ai)
#pragma unroll
            for (int m = 0; m < 4; ++m) { const int row = row0 + ai * HALF + m * 16;
#pragma unroll
                for (int bj = 0; bj < 2; ++bj) { const int c0 = colt + bj * HALF + wc * 32 + 8 * fq;
                    float* p = dout + (size_t)row * DMOD + c0;
                    f32x4 r0 = *(const f32x4*)p, r1 = *(const f32x4*)(p + 4);
                    r0 = r0 * DN_ALPHA_F + acc[ai][bj][m][0]; r1 = r1 * DN_ALPHA_F + acc[ai][bj][m][1];
                    *(f32x4*)p = r0; *(f32x4*)(p + 4) = r1; } }
    }
};
template <class Epi, class Sched, bool ALIGN_EPI = false, bool SP2 = false>
__device__ __forceinline__ void gemm_phase(PG8_LAS unsigned char* lds, const Gemm g, const Sched& S, const Epi& E) {
    int tid_o = threadIdx.x; asm volatile("" : "+v"(tid_o));
    const int tid = tid_o, wid = __builtin_amdgcn_readfirstlane(tid >> 6), lane = tid & 63, wr = wid >> 2, wc = wid & 3, fr = lane & 15, fq = lane >> 4;
    const int K = g.K, nt = K / BK;
    unsigned voffA[2], voffB[2];
#pragma unroll
    for (int i = 0; i < 2; ++i) { int R, C; stage_rc(tid * 16 + i * 8192, R, C); const int Rb = Epi::PERM ? ((R & ~31) + perm32(R & 31)) : R;
        voffA[i] = (unsigned)(R * K + C) * 2u; voffB[i] = (unsigned)(Rb * K + C) * 2u; }
    const size_t kstep = (size_t)(BK * 2);
    const size_t hstep = (size_t)HALF * K * 2;
    const size_t tstep = 2 * hstep;
    const unsigned ldsw = (unsigned)wid * 1024u;
    const int aoff = lds_byte(wr * 64 + fr, fq * 8), boff = lds_byte(wc * 32 + fr, fq * 8);
#define PG8_SA(b, h) (((b) * 2 + (h)) * HTB)
#define PG8_SB(b, h) ((4 + (b) * 2 + (h)) * HTB)
#define PG8_STAGE(bufoff, gbase, voff) do { _Pragma("unroll") for (int _i = 0; _i < 2; ++_i) \
        __builtin_amdgcn_global_load_lds((const unsigned*)((const char*)(gbase) + (voff)[_i]), (PG8_LAS unsigned*)(lds + (bufoff) + ldsw + _i * 8192), 16, 0, 0); } while (0)
#define PG8_LDA(dst, b, h) do { _Pragma("unroll") for (int m = 0; m < 4; ++m) _Pragma("unroll") for (int k = 0; k < 2; ++k) dst[m][k] = *(const PG8_LAS bf16x8*)(lds + PG8_SA(b, h) + aoff + m * 2048 + k * 1024); } while (0)
#define PG8_LDB(dst, b, h) do { _Pragma("unroll") for (int n = 0; n < 2; ++n) _Pragma("unroll") for (int k = 0; k < 2; ++k) dst[n][k] = *(const PG8_LAS bf16x8*)(lds + PG8_SB(b, h) + boff + n * 2048 + k * 1024); } while (0)
#define PG8_MMA(ai, bj, At, Bt) do { __builtin_amdgcn_s_setprio(1); _Pragma("unroll") for (int m = 0; m < 4; ++m) _Pragma("unroll") for (int n = 0; n < 2; ++n) _Pragma("unroll") for (int k = 0; k < 2; ++k) \
        acc[ai][bj][m][n] = __builtin_amdgcn_mfma_f32_16x16x32_bf16(Bt[n][k], At[m][k], acc[ai][bj][m][n], 0, 0, 0); __builtin_amdgcn_s_setprio(0); } while (0)
#define PG8_WAIT_V(n) asm volatile("s_waitcnt vmcnt(" #n ")" ::: "memory")
#define PG8_WAIT_L(n) asm volatile("s_waitcnt lgkmcnt(" #n ")" ::: "memory")
#define PG8_BAR __builtin_amdgcn_s_barrier()
#define PG8_SCHED __builtin_amdgcn_sched_barrier(0)
    Unit cur, nxt; int ui = 0;
    if (!S.next(0, cur)) return;
    f32x4 acc[2][2][4][2];
#pragma unroll
    for (int a = 0; a < 2; ++a)
#pragma unroll
        for (int b = 0; b < 2; ++b)
#pragma unroll
            for (int m = 0; m < 4; ++m)
#pragma unroll
                for (int n = 0; n < 2; ++n) acc[a][b][m][n] = (f32x4){0.f, 0.f, 0.f, 0.f};
    bf16x8 At[4][2], B0[2][2], B1[2][2];
    const char* cA = (const char*)g.A + (size_t)cur.pm * tstep; const char* cB = (const char*)g.Bt + (size_t)cur.pn * tstep;
    S.a_ready(cur);
    if constexpr (SP2) {
        PG8_STAGE(PG8_SB(0, 0), cB, voffB); PG8_STAGE(PG8_SB(0, 1), cB + hstep, voffB); PG8_STAGE(PG8_SA(0, 0), cA, voffA); PG8_STAGE(PG8_SA(0, 1), cA + hstep, voffA);
        if (wr == 1) PG8_BAR;
        PG8_WAIT_V(2); PG8_BAR;
        PG8_STAGE(PG8_SB(1, 0), cB + kstep, voffB); PG8_STAGE(PG8_SA(1, 0), cA + kstep, voffA); PG8_STAGE(PG8_SB(1, 1), cB + hstep + kstep, voffB);
        PG8_WAIT_V(6); PG8_BAR;
    } else {
        PG8_STAGE(PG8_SB(0, 0), cB, voffB); PG8_STAGE(PG8_SA(0, 0), cA, voffA); PG8_STAGE(PG8_SB(0, 1), cB + hstep, voffB); PG8_STAGE(PG8_SA(0, 1), cA + hstep, voffA);
        if (wr == 1) PG8_BAR;
        PG8_WAIT_V(4); PG8_BAR;
        PG8_STAGE(PG8_SB(1, 0), cB + kstep, voffB); PG8_STAGE(PG8_SA(1, 0), cA + kstep, voffA); PG8_STAGE(PG8_SB(1, 1), cB + hstep + kstep, voffB);
        PG8_WAIT_V(6); PG8_BAR;
    }
    for (;;) {
        const bool has_next = S.next(ui + 1, nxt);
        const char* nA = has_next ? (const char*)g.A + (size_t)nxt.pm * tstep : cA; const char* nB = has_next ? (const char*)g.Bt + (size_t)nxt.pn * tstep : cB;
        for (int t = 0; t < nt; t += 2) {
            const bool last = (t == nt - 2);
            const char* a1 = cA + (size_t)(t + 1) * kstep;
            const char* a2 = last ? nA : cA + (size_t)(t + 2) * kstep; const char* b2 = last ? nB : cB + (size_t)(t + 2) * kstep;
            const char* a3 = a2 + kstep; const char* b3 = b2 + kstep;
            if (last && has_next) S.a_ready(nxt);
            if constexpr (SP2) {
            PG8_LDB(B0, 0, 0); PG8_LDB(B1, 0, 1); PG8_SCHED; PG8_LDA(At, 0, 0); PG8_STAGE(PG8_SA(1, 1), a1 + hstep, voffA);
            PG8_WAIT_V(8); PG8_WAIT_L(0); PG8_BAR; PG8_MMA(0, 0, At, B0); PG8_MMA(0, 1, At, B1); PG8_BAR; PG8_SCHED;
            PG8_LDA(At, 0, 1); PG8_STAGE(PG8_SB(0, 0), b2, voffB); PG8_STAGE(PG8_SB(0, 1), b2 + hstep, voffB); PG8_STAGE(PG8_SA(0, 0), a2, voffA);
            PG8_WAIT_V(8); PG8_WAIT_L(0); PG8_BAR; PG8_MMA(1, 0, At, B0); PG8_MMA(1, 1, At, B1); PG8_BAR; PG8_SCHED;
            PG8_LDB(B0, 1, 0); PG8_LDB(B1, 1, 1); PG8_SCHED; PG8_LDA(At, 1, 0); PG8_STAGE(PG8_SA(0, 1), a2 + hstep, voffA);
            PG8_WAIT_V(8); PG8_WAIT_L(0); PG8_BAR; PG8_MMA(0, 0, At, B0); PG8_MMA(0, 1, At, B1); PG8_BAR; PG8_SCHED;
            PG8_LDA(At, 1, 1); PG8_STAGE(PG8_SB(1, 0), b3, voffB); PG8_STAGE(PG8_SB(1, 1), b3 + hstep, voffB); PG8_STAGE(PG8_SA(1, 0), a3, voffA);
            PG8_WAIT_V(8); PG8_WAIT_L(0); PG8_BAR; PG8_MMA(1, 0, At, B0); PG8_MMA(1, 1, At, B1); PG8_BAR; PG8_SCHED;
            } else {
            PG8_LDB(B0, 0, 0); PG8_SCHED; PG8_LDA(At, 0, 0); PG8_STAGE(PG8_SA(1, 1), a1 + hstep, voffA);
            PG8_WAIT_L(8); PG8_BAR; PG8_WAIT_L(0); PG8_MMA(0, 0, At, B0); PG8_BAR; PG8_SCHED;
            PG8_LDB(B1, 0, 1); PG8_STAGE(PG8_SB(0, 0), b2, voffB);
            PG8_BAR; PG8_WAIT_L(0); PG8_MMA(0, 1, At, B1); PG8_BAR;
            PG8_LDA(At, 0, 1); PG8_STAGE(PG8_SA(0, 0), a2, voffA);
            PG8_BAR; PG8_WAIT_L(0); PG8_MMA(1, 0, At, B0); PG8_BAR; PG8_SCHED;
            PG8_STAGE(PG8_SB(0, 1), b2 + hstep, voffB);
            PG8_WAIT_V(6); PG8_BAR; PG8_MMA(1, 1, At, B1); PG8_BAR;
            PG8_LDB(B0, 1, 0); PG8_SCHED; PG8_LDA(At, 1, 0); PG8_STAGE(PG8_SA(0, 1), a2 + hstep, voffA);
            PG8_WAIT_L(8); PG8_BAR; PG8_WAIT_L(0); PG8_MMA(0, 0, At, B0); PG8_BAR; PG8_SCHED;
            PG8_LDB(B1, 1, 1); PG8_STAGE(PG8_SB(1, 0), b3, voffB);
            PG8_BAR; PG8_WAIT_L(0); PG8_MMA(0, 1, At, B1); PG8_BAR;
            PG8_LDA(At, 1, 1); PG8_STAGE(PG8_SA(1, 0), a3, voffA);
            PG8_BAR; PG8_WAIT_L(0); PG8_MMA(1, 0, At, B0); PG8_BAR; PG8_SCHED;
            PG8_STAGE(PG8_SB(1, 1), b3 + hstep, voffB);
            PG8_WAIT_V(6); PG8_BAR; PG8_MMA(1, 1, At, B1); PG8_BAR;
            }
        }
        if constexpr (ALIGN_EPI) { if (wr == 0) PG8_BAR; }
        if constexpr (!Epi::AFTER_DRAIN) { E(acc, cur, wr, wc, fr, fq); S.done(cur); }
        if (!has_next) break;
#pragma unroll
        for (int a = 0; a < 2; ++a)
#pragma unroll
            for (int b = 0; b < 2; ++b)
#pragma unroll
                for (int m = 0; m < 4; ++m)
#pragma unroll
                    for (int n = 0; n < 2; ++n) acc[a][b][m][n] = (f32x4){0.f, 0.f, 0.f, 0.f};
        cur = nxt; cA = nA; cB = nB; ++ui;
        if constexpr (ALIGN_EPI) { if (wr == 1) PG8_BAR; }
    }
    PG8_WAIT_V(0);
    if constexpr (!ALIGN_EPI) { if (wr == 0) PG8_BAR; }
    PG8_BAR;
    if constexpr (Epi::AFTER_DRAIN) { E.fused(acc, cur, wr, wc, fr, fq, lds, wid, lane); S.done(cur); }
#undef PG8_SA
#undef PG8_SB
#undef PG8_STAGE
#undef PG8_LDA
#undef PG8_LDB
#undef PG8_MMA
#undef PG8_WAIT_V
#undef PG8_WAIT_L
#undef PG8_BAR
#undef PG8_SCHED
}
}
#define GAS __attribute__((address_space(1)))
#define LAS __attribute__((address_space(3)))
typedef unsigned short bf16;
typedef unsigned v4u __attribute__((ext_vector_type(4)));
typedef float f32x4 __attribute__((ext_vector_type(4)));
typedef short bf16x8 __attribute__((ext_vector_type(8)));
typedef GAS unsigned gu32;
typedef GAS unsigned long long gu64;
#define RLX_AGENT __ATOMIC_RELAXED, __HIP_MEMORY_SCOPE_AGENT
#define LDS_WAIT() asm volatile("s_waitcnt lgkmcnt(0)" ::: "memory")
#define VM_WAIT() asm volatile("s_waitcnt vmcnt(0)" ::: "memory")
__device__ __forceinline__ unsigned long long rt() { return __builtin_amdgcn_s_memrealtime(); }
__device__ __forceinline__ unsigned f2bf(float f) { unsigned u = __builtin_bit_cast(unsigned, f); return (u + 0x7fffu + ((u >> 16) & 1u)) >> 16; }
__device__ __forceinline__ unsigned pk2(float lo, float hi) { return f2bf(lo) | (f2bf(hi) << 16); }

#define XB_TMO      128
#define XB_XCNT(j)  (256  + 64 * (j))
#define XB_XSUB(j)  (1280 + 64 * (j))
#define XB_XGEN(j)  (2304 + 64 * (j))
#define XB_TOP      3328
#define XB_TOPGEN   3392
#define XCD_BAR_WORDS 3456
#define XB_SPIN_CAP (1u << 18)

__device__ __forceinline__ unsigned xb_ld(unsigned* p)              { return __hip_atomic_load(p, __ATOMIC_RELAXED, __HIP_MEMORY_SCOPE_AGENT); }
__device__ __forceinline__ unsigned xb_add(unsigned* p, unsigned v) { return __hip_atomic_fetch_add(p, v, __ATOMIC_RELAXED, __HIP_MEMORY_SCOPE_AGENT); }
__device__ __forceinline__ unsigned xb_xcc_id() { return (unsigned)__builtin_amdgcn_s_getreg((3 << 11) | 20) & 0xFu; }
#define XB_SPIN(cond, bar) do { unsigned _sp = 0; while (cond) { __builtin_amdgcn_s_sleep(1); \
    if ((++_sp & 255u) == 0u) { if (xb_ld(&(bar)[XB_TMO])) break; if (_sp > XB_SPIN_CAP) { atomicAdd(&(bar)[XB_TMO], 1u); break; } } } } while (0)

struct XcdBarrier {
    unsigned* bar; unsigned x;
    volatile LAS unsigned* st;
};

__device__ __forceinline__ XcdBarrier xcd_barrier_post(unsigned* bar, volatile LAS unsigned* st) {
    XcdBarrier b; b.bar = bar; b.x = xb_xcc_id(); b.st = st;
    if (threadIdx.x == 0) (void)xb_add(&bar[XB_XCNT(b.x)], 1u);
    return b;
}
__device__ __forceinline__ void xcd_barrier_complete(unsigned* bar, unsigned x, unsigned& nloc, unsigned& nx) {
    const unsigned G = gridDim.x * gridDim.y * gridDim.z;
    unsigned sum, cnt, mine, sp = 0u;
    for (;;) {
        sum = 0u; cnt = 0u; mine = 0u;
#pragma unroll
        for (unsigned j = 0; j < 16; ++j) { const unsigned c = xb_ld(&bar[XB_XCNT(j)]); sum += c; cnt += (c > 0u) ? 1u : 0u; mine = (j == x) ? c : mine; }
        if (sum == G) break;
        __builtin_amdgcn_s_sleep(1);
        if ((++sp & 255u) == 0u) { if (xb_ld(&bar[XB_TMO])) break; if (sp > XB_SPIN_CAP) { atomicAdd(&bar[XB_TMO], 1u); break; } }
    }
    nloc = mine > 0u ? mine : 1u; nx = cnt > 0u ? cnt : 1u;
}

__device__ __forceinline__ void xcd_barrier(const XcdBarrier& b) {
    asm volatile("s_waitcnt vmcnt(0)" ::: "memory");
    __syncthreads();
    if (threadIdx.x == 0) {
        unsigned* bar = b.bar;
        __builtin_amdgcn_s_waitcnt(0);
        unsigned nloc = b.st[0], nx = b.st[1];
        if (nloc == 0u) { xcd_barrier_complete(bar, b.x, nloc, nx); b.st[0] = nloc; b.st[1] = nx; }
        const unsigned old = xb_add(&bar[XB_XSUB(b.x)], 1u);
        const unsigned gen = old / nloc;
        if (old + 1u == (gen + 1u) * nloc) {
            __builtin_amdgcn_fence(__ATOMIC_RELEASE, "agent");
            asm volatile("s_waitcnt vmcnt(0)" ::: "memory");
            const unsigned og = xb_add(&bar[XB_TOP], 1u);
            const unsigned tg = og / nx;
            if (og + 1u == (tg + 1u) * nx) xb_add(&bar[XB_TOPGEN], 1u);
            else XB_SPIN(xb_ld(&bar[XB_TOPGEN]) == tg, bar);
            __builtin_amdgcn_fence(__ATOMIC_ACQUIRE, "agent");
            xb_add(&bar[XB_XGEN(b.x)], 1u);
            asm volatile("s_waitcnt vmcnt(0)" ::: "memory");
        } else {
            XB_SPIN(xb_ld(&bar[XB_XGEN(b.x)]) == gen, bar);
            __builtin_amdgcn_fence(__ATOMIC_ACQUIRE, "agent");
            asm volatile("s_waitcnt vmcnt(0)" ::: "memory");
        }
    }
    __syncthreads();
}

using pg8::bf16_t; using pg8::MTOK; using pg8::LP; using pg8::LS; using pg8::DMOD; using pg8::DIN; using pg8::QKVG_W;
typedef unsigned u32x4_t __attribute__((ext_vector_type(4)));
typedef float f32x4_t __attribute__((ext_vector_type(4)));
__device__ __forceinline__ float bf2f(unsigned short b) { return __uint_as_float(((unsigned)b) << 16); }

constexpr size_t MiB = 1u << 20;
constexpr size_t WS_CTL = 0, CTL_ZERO_BYTES = 64 * 1024;
constexpr size_t WS_NRM = 512 * 1024;
constexpr size_t WS_WIN = 1 * MiB, WS_WOUT = 27 * MiB, WS_SMALL = 35 * MiB, WS_HB = 40 * MiB, WS_QKVG = 136 * MiB, WS_GH = 256 * MiB, WS_HYT = 304 * MiB, WS_WIN1 = 448 * MiB, WS_WOUT1 = 474 * MiB, WS_ROPE = 488 * MiB, WS_END = 489 * MiB;
constexpr int CW_BAR = 1024;
constexpr int RING_BYTES = 131072, LDSCTL_OFF = 159744, MISC_OFF = LDSCTL_OFF + 320, LDS_BYTES = 163840;
constexpr int NWAVES = 8, NTHR = 512;

struct Args { const float* in[22]; float* out; unsigned char* ws; };

struct Ctx {
    int tid; int G; int bx;
    unsigned char* lds_g;
    const float *x_prompt, *x_sample, *emb_g, *emb_b, *w_in, *sink, *conv_w, *conv_b, *fw1, *fb1, *ff1, *fw2, *fb2, *ff2, *fw3, *fdec, *hyd, *ang, *hng, *w_out, *lng, *lnb;
    float* dout; bf16_t *WIN, *WOUT, *WIN1, *WOUT1, *HB, *QKVG, *GH, *HYT, *UT0, *UT1, *ZT, *A2, *H2B; float *ROPE;
};
__device__ __forceinline__ void seq_of_row(int m, int& start, int& L, int& pos) {
    if (m < LP) { start = 0; L = LP; pos = m; } else { const int r = m - LP; start = LP + (r / LS) * LS; L = LS; pos = r % LS; }
}
#define OPAQUE_TID(t) int t = threadIdx.x; asm volatile("" : "+v"(t))
#define VB_SETUP(BS) OPAQUE_TID(otid_); const int per_ = NTHR / (BS); const int vsub = otid_ / (BS); const int vtid = otid_ % (BS); (void)vsub; (void)vtid; (void)per_
#define VB_FOR(nvb) for (int it_ = C.bx; it_ * per_ < (nvb); it_ += C.G)

__device__ __forceinline__ void ph_transpose(const Ctx& C, const float* W, bf16_t* WT, int K, int N) {
    VB_SETUP(256); float* t = (float*)C.lds_g + vsub * (32 * 33); const int nbx = N / 32, nvb = nbx * (K / 32);
    VB_FOR(nvb) { const int vb = it_ * per_ + vsub; const int n0 = (vb % nbx) * 32, k0 = (vb / nbx) * 32, tx = vtid & 31, ty = vtid >> 5;
        __syncthreads();
        for (int i = 0; i < 4; ++i) t[(ty + 8 * i) * 33 + tx] = W[(size_t)(k0 + ty + 8 * i) * N + n0 + tx];
        __syncthreads();
        for (int i = 0; i < 4; ++i) WT[(size_t)(n0 + ty + 8 * i) * K + k0 + tx] = (bf16_t)f2bf(t[tx * 33 + ty + 8 * i]); }
    __syncthreads();
}
__device__ __forceinline__ void ph_ln_rows(const Ctx& C, const float* in0, const float* in1, int split, const float* g, const float* b, float* outf, bf16_t* outb) {
    VB_SETUP(256); float* red = (float*)C.lds_g + vsub * 8;
    VB_FOR(MTOK) { const int m = it_ * per_ + vsub; const int tid = vtid;
        const float* src = (m < split) ? in0 + (size_t)m * DMOD : in1 + (size_t)(m - split) * DMOD;
        f32x4_t v0 = *(const f32x4_t*)(src + tid * 8), v1 = *(const f32x4_t*)(src + tid * 8 + 4);
        float s = (v0[0] + v0[1]) + (v0[2] + v0[3]) + (v1[0] + v1[1]) + (v1[2] + v1[3]);
        for (int o = 1; o < 64; o <<= 1) s += __shfl_xor(s, o);
        __syncthreads();
        if ((tid & 63) == 0) red[tid >> 6] = s;
        __syncthreads();
        const float mean = (red[0] + red[1] + red[2] + red[3]) * (1.0f / DMOD);
        v0 = v0 - mean; v1 = v1 - mean;
        float q = (v0[0] * v0[0] + v0[1] * v0[1]) + (v0[2] * v0[2] + v0[3] * v0[3]) + (v1[0] * v1[0] + v1[1] * v1[1]) + (v1[2] * v1[2] + v1[3] * v1[3]);
        for (int o = 1; o < 64; o <<= 1) q += __shfl_xor(q, o);
        if ((tid & 63) == 0) red[4 + (tid >> 6)] = q;
        __syncthreads();
        const float rstd = rsqrtf((red[4] + red[5] + red[6] + red[7]) * (1.0f / DMOD) + 1e-5f);
        const f32x4_t g0 = *(const f32x4_t*)(g + tid * 8), g1 = *(const f32x4_t*)(g + tid * 8 + 4), b0 = *(const f32x4_t*)(b + tid * 8), b1 = *(const f32x4_t*)(b + tid * 8 + 4);
        v0 = v0 * rstd * g0 + b0; v1 = v1 * rstd * g1 + b1;
        *(f32x4_t*)(outf + (size_t)m * DMOD + tid * 8) = v0; *(f32x4_t*)(outf + (size_t)m * DMOD + tid * 8 + 4) = v1;
        u32x4_t w; w.x = pk2(v0[0], v0[1]); w.y = pk2(v0[2], v0[3]); w.z = pk2(v1[0], v1[1]); w.w = pk2(v1[2], v1[3]);
        *(u32x4_t*)(outb + (size_t)m * DMOD + tid * 8) = w; }
    __syncthreads();
}
__device__ __forceinline__ void ph_rope_table(const Ctx& C) {
    OPAQUE_TID(otid_);
    for (int idx = C.bx * NTHR + otid_; idx < LP * 8; idx += C.G * NTHR) { const int pos = idx >> 3, i = idx & 7;
        const float inv = powf(500000.0f, -(float)(2 * i) / 16.0f); const float ang = (float)pos * inv;
        C.ROPE[pos * 16 + i] = cosf(ang); C.ROPE[pos * 16 + 8 + i] = sinf(ang); }
}
__device__ __forceinline__ void ph_filt_h2(const Ctx& C, int l, bf16_t* H2, int L) {
    VB_SETUP(64); float* z = (float*)C.lds_g + vsub * 128; float* h1 = z + 40;
    const float* w1 = C.fw1 + l * 33 * 64; const float* b1 = C.fb1 + l * 64; const float* f1 = C.ff1 + l * 64; const float* w2 = C.fw2 + l * 64 * 64; const float* b2 = C.fb2 + l * 64; const float* f2 = C.ff2 + l * 64;
    VB_FOR(L) { const int pos = it_ * per_ + vsub, j = vtid;
        __syncthreads();
        if (j < 33) { float v;
            if (j == 0) v = (float)pos / (float)(L - 1);
            else { const int k = (j - 1) & 15; const float band = 1e-4f + (float)k * ((15.0f - 1e-4f) / 15.0f);
                   const float w = 6.283185307179586f * (float)pos / (float)L; const float ang = w * band;
                   v = (j <= 16) ? cosf(ang) : -sinf(ang); }
            z[j] = v; }
        __syncthreads();
        float a = b1[j]; for (int i = 0; i < 33; ++i) a += z[i] * w1[i * 64 + j];
        h1[j] = sinf(f1[j] * a);
        __syncthreads();
        float c = b2[j]; for (int i = 0; i < 64; ++i) c += h1[i] * w2[i * 64 + j];
        H2[pos * 64 + j] = (bf16_t)f2bf(sinf(f2[j] * c)); }
    __syncthreads();
}
__device__ __forceinline__ void ph_norm_gate(const Ctx& C, int l) {
    VB_SETUP(256); float* red = (float*)C.lds_g + vsub * 8; const float* ag = C.ang + l * 1024; const float* hg = C.hng + l * 1024;
    VB_FOR(MTOK) { const int m = it_ * per_ + vsub, tid = vtid;
        float a[4], z[4]; float sa = 0.f, sz = 0.f;
        for (int i = 0; i < 4; ++i) { const int j = tid + 256 * i; a[i] = bf2f(C.QKVG[(size_t)m * QKVG_W + j]); z[i] = bf2f(C.ZT[(size_t)j * MTOK + m]); sa += a[i] * a[i]; sz += z[i] * z[i]; }
        for (int o = 1; o < 64; o <<= 1) { sa += __shfl_xor(sa, o); sz += __shfl_xor(sz, o); }
        __syncthreads();
        if ((tid & 63) == 0) { red[tid >> 6] = sa; red[4 + (tid >> 6)] = sz; }
        __syncthreads();
        const float ra = rsqrtf((red[0] + red[1] + red[2] + red[3]) * (1.0f / 1024.0f) + 1e-5f), rz = rsqrtf((red[4] + red[5] + red[6] + red[7]) * (1.0f / 1024.0f) + 1e-5f);
        for (int i = 0; i < 4; ++i) { const int j = tid + 256 * i;
            C.A2[(size_t)m * DMOD + j] = (bf16_t)f2bf(a[i] * ra * ag[j] * bf2f(C.QKVG[(size_t)m * QKVG_W + 1536 + j]));
            C.A2[(size_t)m * DMOD + 1024 + j] = (bf16_t)f2bf(z[i] * rz * hg[j] * bf2f(C.GH[(size_t)m * 1024 + j])); } }
    __syncthreads();
}


typedef short cj_bf16x8 __attribute__((ext_vector_type(8)));
typedef float cj_f32x4 __attribute__((ext_vector_type(4)));
typedef unsigned cj_u32x2 __attribute__((ext_vector_type(2)));

template <int NB16, int NSQ, int NPASS>
__device__ __forceinline__ void conv_job(const Ctx& C, int l, int grp, LAS unsigned char* lds3, const bf16_t* H2B, int seq_base0) {
    constexpr int L = NB16 * 512, NB = NB16 * 16, RLEN = 2 * L + 128, RC = L + 32, RBYTES = RLEN * 2;
    constexpr int NRM_OFF = 4 * RBYTES;
    static_assert(NRM_OFF + 8 * 8 * 4 + 16 <= LDSCTL_OFF, "conv job LDS");
    OPAQUE_TID(tid);
    const int lane = tid & 63, wid = __builtin_amdgcn_readfirstlane(tid >> 6), cc = wid & 3, mi = wid >> 2;
    const int r16 = lane & 15, g4 = lane >> 4;
    const int c0 = grp * 4, c = c0 + cc;
    const float* cw = C.conv_w + (size_t)l * 3 * 3072; const float* cb = C.conv_b + (size_t)l * 3072;
    LAS float* part = (LAS float*)(lds3 + NRM_OFF); LAS float* nrmv = part + 64;

    { constexpr int CH = NSQ * NPASS * L / 8;
      for (int idx = tid; idx < 4 * CH; idx += NTHR) { const int ch = idx / CH, q = idx % CH; const int cidx_ = c0 + ch;
          const int sq = q / (L / 8), t = (q % (L / 8)) * 8; const size_t off = (size_t)cidx_ * MTOK + seq_base0 + sq * L + t;
          const u32x4_t w = *(const u32x4_t*)(C.HYT + off);
          float h[10]; h[0] = t > 0 ? bf2f(C.HYT[off - 1]) : 0.f; h[9] = t + 8 < L ? bf2f(C.HYT[off + 8]) : 0.f;
#pragma unroll
          for (int e = 0; e < 4; ++e) { h[1 + 2 * e] = __uint_as_float(w[e] << 16); h[2 + 2 * e] = __uint_as_float(w[e] & 0xffff0000u); }
          const float w0 = cw[cidx_], w1 = cw[3072 + cidx_], w2 = cw[6144 + cidx_], bb = cb[cidx_];
          float o[8];
#pragma unroll
          for (int e = 0; e < 8; ++e) o[e] = h[e] * w0 + h[e + 1] * w1 + h[e + 2] * w2 + bb;
          u32x4_t ow; ow.x = pk2(o[0], o[1]); ow.y = pk2(o[2], o[3]); ow.z = pk2(o[4], o[5]); ow.w = pk2(o[6], o[7]);
          *(u32x4_t*)(C.UT0 + off) = ow; } }

#pragma unroll 1
    for (int order = 0; order < 2; ++order) {
        __syncthreads();
        {
          for (int idx = tid; idx < 4 * (33 + 96); idx += NTHR) { const int ch = idx / 129, q = idx % 129; const int x = q < 33 ? q : (2 * L + 32 + (q - 33));
              *(LAS unsigned short*)(lds3 + ch * RBYTES + 2 * x) = 0; }
          const float* w3 = C.fw3 + (size_t)l * 64 * 4096; const float* decay = C.fdec + (size_t)l * 4096;
          const int col = r16; const bool cv = col < 8; const int dir = (col >> 2) & 1, fch = col & 3;
          const int fidx = order * 2048 + dir * 1024 + c0 + fch;
          cj_bf16x8 Bw[2];
#pragma unroll
          for (int ks = 0; ks < 2; ++ks) { unsigned wv[4];
#pragma unroll
              for (int j = 0; j < 4; ++j) { const int k = 32 * ks + 8 * g4 + 2 * j; const float a = cv ? w3[(size_t)k * 4096 + fidx] : 0.f, b = cv ? w3[(size_t)(k + 1) * 4096 + fidx] : 0.f; wv[j] = pk2(a, b); }
              Bw[ks] = __builtin_bit_cast(cj_bf16x8, (u32x4_t){wv[0], wv[1], wv[2], wv[3]}); }
          const float kd = cv ? fabsf(decay[fidx]) * (1.4426950408889634f / (float)(L - 1)) : 0.f;
          float nacc = 0.f;
          LAS unsigned char* Rw = lds3 + fch * RBYTES;
          for (int mt = wid; mt < L / 16; mt += NWAVES) { const int p0 = mt * 16;
              const cj_bf16x8 A0 = *(const cj_bf16x8*)(H2B + (size_t)(p0 + r16) * 64 + 8 * g4), A1 = *(const cj_bf16x8*)(H2B + (size_t)(p0 + r16) * 64 + 32 + 8 * g4);
              cj_f32x4 d = {0.f, 0.f, 0.f, 0.f};
              d = __builtin_amdgcn_mfma_f32_16x16x32_bf16(A0, Bw[0], d, 0, 0, 0);
              d = __builtin_amdgcn_mfma_f32_16x16x32_bf16(A1, Bw[1], d, 0, 0, 0);
#pragma unroll
              for (int rg = 0; rg < 4; ++rg) { const int pos = p0 + 4 * g4 + rg; const float v = d[rg] * __builtin_amdgcn_exp2f(-(float)pos * kd);
                  nacc += fabsf(v);
                  const int x = dir ? RC + pos : RC - pos;
                  if (cv && !(dir && pos == 0)) *(LAS unsigned short*)(Rw + 2 * x) = (unsigned short)f2bf(v); } }
          nacc += __shfl_xor(nacc, 16); nacc += __shfl_xor(nacc, 32);
          if (lane < 8) { LAS float* pw = part + wid * 8 + lane; asm volatile("" : "+v"(pw)); pw[0] = nacc; } }
        asm volatile("s_waitcnt vmcnt(0) lgkmcnt(0)" ::: "memory");
        __syncthreads();
        if (tid < 4) { LAS float* pb = part + tid; asm volatile("" : "+v"(pb)); float s = 0.f; for (int w = 0; w < 8; ++w) s += pb[w * 8] + pb[w * 8 + 4]; pb[64] = s; }
        __syncthreads();
        float inv_n; { LAS float* pn = nrmv + cc; asm volatile("" : "+v"(pn)); inv_n = 1.0f / pn[0]; }
        const float dd = C.hyd[(size_t)l * 2048 + order * 1024 + c];
        const bf16_t* U = (order == 0 ? C.UT0 : C.UT1) + (size_t)c * MTOK;
        bf16_t* Zo = (order == 0 ? C.UT1 : C.ZT) + (size_t)c * MTOK;
        const int gc = 1024 * (order + 1) + c; const bf16_t* HG = C.HYT + (size_t)gc * MTOK;
        const float gw0 = cw[gc], gw1 = cw[3072 + gc], gw2 = cw[6144 + gc], gbb = cb[gc];
        const int xb = RC - 16 * mi - r16 + 8 * g4; const int par = xb & 1; const unsigned sh = (unsigned)par * 16u;
        const unsigned abase0 = (unsigned)(cc * RBYTES + 2 * (xb - par) - (NB16 - 1) * 1024);

#pragma unroll 1
        for (int pass = 0; pass < NPASS; ++pass) {
            const int sbase = seq_base0 + pass * NSQ * L;
            cj_f32x4 acc[NSQ][NB16];
#pragma unroll
            for (int sq = 0; sq < NSQ; ++sq)
#pragma unroll
                for (int n = 0; n < NB16; ++n) acc[sq][n] = (cj_f32x4){0.f, 0.f, 0.f, 0.f};
#pragma unroll 1
            for (int ff = 0; ff < 16; ++ff) { const int f = (ff + 8 * mi) & 15;
                cj_bf16x8 Bf[NSQ][NB16 + 1];
                const bf16_t* ub = U + sbase + 8 * g4 + 32 * (r16 - f);
#pragma unroll
                for (int sq = 0; sq < NSQ; ++sq)
#pragma unroll
                    for (int mp = 0; mp <= NB16; ++mp) { const int ab = 16 * mp + r16 - f;
                        if (mp == 0) { const bool ok = ab >= 0; cj_bf16x8 v = *(const cj_bf16x8*)(ub + sq * L + (ok ? 0 : 32 * f - 32 * r16)); if (!ok) v = (cj_bf16x8){0, 0, 0, 0, 0, 0, 0, 0}; Bf[sq][mp] = v; }
                        else if (mp == NB16) { const bool ok = ab < NB; cj_bf16x8 v = *(const cj_bf16x8*)(ub + sq * L + (ok ? 512 * NB16 : 0)); if (!ok) v = (cj_bf16x8){0, 0, 0, 0, 0, 0, 0, 0}; Bf[sq][mp] = v; }
                        else Bf[sq][mp] = *(const cj_bf16x8*)(ub + sq * L + 512 * mp); }
                const LAS unsigned* ap = (const LAS unsigned*)(lds3 + (abase0 - 64u * (unsigned)f));
                asm volatile("" : "+v"(ap));
                unsigned raw[2][5];
                { raw[0][0] = ap[0]; raw[0][1] = ap[1]; raw[0][2] = ap[2]; raw[0][3] = ap[3]; raw[0][4] = ap[4]; }
#pragma unroll
                for (int ei = 0; ei < 2 * NB16; ++ei) { const int e = NB16 - 1 - ei; const int cb_ = ei & 1, nb_ = cb_ ^ 1;
                    if (ei + 1 < 2 * NB16) { ap += 256; asm volatile("" : "+v"(ap)); raw[nb_][0] = ap[0]; raw[nb_][1] = ap[1]; raw[nb_][2] = ap[2]; raw[nb_][3] = ap[3]; raw[nb_][4] = ap[4]; }
                    u32x4_t aw; aw.x = __builtin_amdgcn_alignbit(raw[cb_][1], raw[cb_][0], sh); aw.y = __builtin_amdgcn_alignbit(raw[cb_][2], raw[cb_][1], sh);
                    aw.z = __builtin_amdgcn_alignbit(raw[cb_][3], raw[cb_][2], sh); aw.w = __builtin_amdgcn_alignbit(raw[cb_][4], raw[cb_][3], sh);
                    const cj_bf16x8 A = __builtin_bit_cast(cj_bf16x8, aw);
#pragma unroll
                    for (int sq = 0; sq < NSQ; ++sq)
#pragma unroll
                        for (int n = 0; n < NB16; ++n) { const int mp = n - e; if (mp >= 0 && mp <= NB16) acc[sq][n] = __builtin_amdgcn_mfma_f32_16x16x32_bf16(A, Bf[sq][mp], acc[sq][n], 0, 0, 0); }
                    __builtin_amdgcn_sched_barrier(0); }
            }
#pragma unroll
            for (int sq = 0; sq < NSQ; ++sq)
#pragma unroll
                for (int n = 0; n < NB16; ++n) { const int t0 = 32 * (16 * n + r16) + 16 * mi + 4 * g4; const size_t off = (size_t)sbase + sq * L + t0;
                    const cj_u32x2 uw = *(const cj_u32x2*)(U + off); const cj_u32x2 hw = *(const cj_u32x2*)(HG + off);
                    float h[6]; h[0] = (n > 0 || t0 > 0) ? bf2f(HG[off - 1]) : 0.f; h[5] = (n < NB16 - 1 || t0 + 4 < L) ? bf2f(HG[off + 4]) : 0.f;
                    h[1] = __uint_as_float(hw.x << 16); h[2] = __uint_as_float(hw.x & 0xffff0000u); h[3] = __uint_as_float(hw.y << 16); h[4] = __uint_as_float(hw.y & 0xffff0000u);
                    float uu[4] = {__uint_as_float(uw.x << 16), __uint_as_float(uw.x & 0xffff0000u), __uint_as_float(uw.y << 16), __uint_as_float(uw.y & 0xffff0000u)};
                    float z[4];
#pragma unroll
                    for (int j = 0; j < 4; ++j) { const float gate = h[j] * gw0 + h[j + 1] * gw1 + h[j + 2] * gw2 + gbb; z[j] = gate * (acc[sq][n][j] * inv_n + dd * uu[j]); }
                    cj_u32x2 ow; ow.x = pk2(z[0], z[1]); ow.y = pk2(z[2], z[3]);
                    *(cj_u32x2*)(Zo + off) = ow; __builtin_amdgcn_sched_barrier(0); }
        }
        asm volatile("s_waitcnt vmcnt(0)" ::: "memory");
    }
    __syncthreads();
}

typedef short at_bf16x8 __attribute__((ext_vector_type(8)));
typedef short at_s16x4 __attribute__((ext_vector_type(4)));
typedef float at_f32x16 __attribute__((ext_vector_type(16)));
constexpr int AT_VT_OFF = 49152, AT_VT_PITCH = 776;
__device__ __forceinline__ float at_exp2(float x) { return __builtin_amdgcn_exp2f(x); }

__device__ __forceinline__ void attn_item(const Ctx& C, const float* sinkp, int item, LAS unsigned char* lds3) {
    OPAQUE_TID(tid);
    const int lane = tid & 63, wid = __builtin_amdgcn_readfirstlane(tid >> 6), r32 = lane & 31, hh = lane >> 5;
    const int qblk = item >> 2, kv = item & 3; const int m0 = qblk * 128;
    int st, L, pos0; seq_of_row(m0, st, L, pos0);
    bf16_t* qkvg = C.QKVG;
    __syncthreads();
    for (int idx = tid; idx < 384 * 8; idx += NTHR) { const int key = idx >> 3, ch = idx & 7; const int pos = pos0 - 128 + key;
        if (pos < 0 || pos >= L) continue;
        const bf16_t* rowp = qkvg + (size_t)(st + pos) * QKVG_W + kv * 64;
        u32x4_t kw = *(const u32x4_t*)(rowp + 1024 + 8 * ch);
        if (ch < 2) { const u32x4_t ow = *(const u32x4_t*)(rowp + 1024 + 8 * (ch ^ 1));
            const f32x4_t c0 = *(const f32x4_t*)(C.ROPE + pos * 16), c1 = *(const f32x4_t*)(C.ROPE + pos * 16 + 4), s0 = *(const f32x4_t*)(C.ROPE + pos * 16 + 8), s1 = *(const f32x4_t*)(C.ROPE + pos * 16 + 12);
            const float cs[8] = {c0[0], c0[1], c0[2], c0[3], c1[0], c1[1], c1[2], c1[3]}, sn[8] = {s0[0], s0[1], s0[2], s0[3], s1[0], s1[1], s1[2], s1[3]};
            float o[8];
#pragma unroll
            for (int e = 0; e < 4; ++e) { const float a0 = __uint_as_float(kw[e] << 16), a1 = __uint_as_float(kw[e] & 0xffff0000u), b0 = __uint_as_float(ow[e] << 16), b1 = __uint_as_float(ow[e] & 0xffff0000u);
                o[2 * e] = ch == 0 ? a0 * cs[2 * e] - b0 * sn[2 * e] : a0 * cs[2 * e] + b0 * sn[2 * e];
                o[2 * e + 1] = ch == 0 ? a1 * cs[2 * e + 1] - b1 * sn[2 * e + 1] : a1 * cs[2 * e + 1] + b1 * sn[2 * e + 1]; }
            kw.x = pk2(o[0], o[1]); kw.y = pk2(o[2], o[3]); kw.z = pk2(o[4], o[5]); kw.w = pk2(o[6], o[7]); }
        *(LAS u32x4_t*)(lds3 + key * 128 + ((ch * 16) ^ ((key & 7) << 4))) = kw;
        const u32x4_t vw = *(const u32x4_t*)(rowp + 1280 + 8 * ch);
        LAS unsigned char* vt = lds3 + AT_VT_OFF + (8 * ch) * AT_VT_PITCH + key * 2;
#pragma unroll
        for (int e = 0; e < 4; ++e) { *(LAS unsigned short*)(vt + (2 * e) * AT_VT_PITCH) = (unsigned short)(vw[e] & 0xffffu); *(LAS unsigned short*)(vt + (2 * e + 1) * AT_VT_PITCH) = (unsigned short)(vw[e] >> 16); } }
    asm volatile("s_waitcnt vmcnt(0) lgkmcnt(0)" ::: "memory");
    __syncthreads();
    const int hq = kv * 4 + (wid >> 1), rh = wid & 1;
    const float sink2 = sinkp[hq] * 1.4426950408889634f;
    constexpr float C2 = 0.125f * 1.4426950408889634f;
    at_bf16x8 qf[2][4];
#pragma unroll
    for (int j = 0; j < 2; ++j) { const int qrel = 64 * rh + 32 * j + r32; const int pos = pos0 + qrel;
        const bf16_t* qp = qkvg + (size_t)(m0 + qrel) * QKVG_W + hq * 64;
#pragma unroll
        for (int s = 0; s < 4; ++s) { const u32x4_t w = *(const u32x4_t*)(qp + 16 * s + 8 * hh); float v[8];
#pragma unroll
            for (int e = 0; e < 4; ++e) { v[2 * e] = __uint_as_float(w[e] << 16); v[2 * e + 1] = __uint_as_float(w[e] & 0xffff0000u); }
            if (s == 0) { const u32x4_t ow = *(const u32x4_t*)(qp + 8 * (hh ^ 1));
                const f32x4_t c0 = *(const f32x4_t*)(C.ROPE + pos * 16), c1 = *(const f32x4_t*)(C.ROPE + pos * 16 + 4), s0 = *(const f32x4_t*)(C.ROPE + pos * 16 + 8), s1 = *(const f32x4_t*)(C.ROPE + pos * 16 + 12);
                const float cs[8] = {c0[0], c0[1], c0[2], c0[3], c1[0], c1[1], c1[2], c1[3]}, sn[8] = {s0[0], s0[1], s0[2], s0[3], s1[0], s1[1], s1[2], s1[3]};
#pragma unroll
                for (int e = 0; e < 4; ++e) { const float b0 = __uint_as_float(ow[e] << 16), b1 = __uint_as_float(ow[e] & 0xffff0000u);
                    v[2 * e] = hh == 0 ? v[2 * e] * cs[2 * e] - b0 * sn[2 * e] : v[2 * e] * cs[2 * e] + b0 * sn[2 * e];
                    v[2 * e + 1] = hh == 0 ? v[2 * e + 1] * cs[2 * e + 1] - b1 * sn[2 * e + 1] : v[2 * e + 1] * cs[2 * e + 1] + b1 * sn[2 * e + 1]; } }
            u32x4_t pw; pw.x = pk2(v[0] * C2, v[1] * C2); pw.y = pk2(v[2] * C2, v[3] * C2); pw.z = pk2(v[4] * C2, v[5] * C2); pw.w = pk2(v[6] * C2, v[7] * C2);
            qf[j][s] = __builtin_bit_cast(at_bf16x8, pw); } }
    at_f32x16 o[2][2];
#pragma unroll
    for (int j = 0; j < 2; ++j)
#pragma unroll
        for (int db = 0; db < 2; ++db)
#pragma unroll
            for (int r = 0; r < 16; ++r) o[j][db][r] = 0.f;
    float mx[2] = {sink2, sink2}, ls[2] = {0.f, 0.f};
    const LAS unsigned char* kbase = lds3 + r32 * 128; const int ksw = (r32 & 7);
    const LAS unsigned char* vbase = lds3 + AT_VT_OFF + r32 * AT_VT_PITCH + 8 * hh;
#pragma unroll 1
    for (int t = 0; t < 10; ++t) { const int kt = 2 * rh + t;
        const int kpos0 = pos0 - 128 + 32 * kt; if (kpos0 < 0 || kpos0 >= L) continue;
        at_bf16x8 kf[4];
#pragma unroll
        for (int s = 0; s < 4; ++s) kf[s] = *(const LAS at_bf16x8*)(kbase + kt * 4096 + (((2 * s + hh) ^ ksw) << 4));
        at_bf16x8 vf[2][2];
#pragma unroll
        for (int db = 0; db < 2; ++db)
#pragma unroll
            for (int s = 0; s < 2; ++s) { const LAS unsigned char* p = vbase + db * 32 * AT_VT_PITCH + (32 * kt + 16 * s) * 2;
                const at_s16x4 lo = *(const LAS at_s16x4*)p, hi = *(const LAS at_s16x4*)(p + 16);
                vf[db][s] = (at_bf16x8){lo[0], lo[1], lo[2], lo[3], hi[0], hi[1], hi[2], hi[3]}; }
#pragma unroll
        for (int j = 0; j < 2; ++j) {
            at_f32x16 sc;
#pragma unroll
            for (int r = 0; r < 16; ++r) sc[r] = 0.f;
#pragma unroll
            for (int s = 0; s < 4; ++s) sc = __builtin_amdgcn_mfma_f32_32x32x16_bf16(kf[s], qf[j][s], sc, 0, 0, 0);
            const int dq = (-128 + 32 * kt + 4 * hh) - (64 * rh + 32 * j + r32);
            float rm = -3.0e38f;
#pragma unroll
            for (int r = 0; r < 16; ++r) { const int dk = dq + (r & 3) + 8 * (r >> 2); const bool ok = (dk >= -128) && (dk <= 128); sc[r] = ok ? sc[r] : -3.0e38f; rm = fmaxf(rm, sc[r]); }
            { const float other = __shfl_xor(rm, 32); rm = fmaxf(rm, other); }
            if (__any(rm > mx[j])) { const float mn = fmaxf(mx[j], rm); const float al = at_exp2(mx[j] - mn); mx[j] = mn; ls[j] *= al;
#pragma unroll
                for (int db = 0; db < 2; ++db)
#pragma unroll
                    for (int r = 0; r < 16; ++r) o[j][db][r] *= al; }
            float psum = 0.f;
#pragma unroll
            for (int r = 0; r < 16; ++r) { sc[r] = at_exp2(sc[r] - mx[j]); psum += sc[r]; }
            ls[j] += psum;
            at_bf16x8 pf[2];
#pragma unroll
            for (int s = 0; s < 2; ++s) { u32x4_t pw; pw.x = pk2(sc[8 * s], sc[8 * s + 1]); pw.y = pk2(sc[8 * s + 2], sc[8 * s + 3]); pw.z = pk2(sc[8 * s + 4], sc[8 * s + 5]); pw.w = pk2(sc[8 * s + 6], sc[8 * s + 7]);
                pf[s] = __builtin_bit_cast(at_bf16x8, pw); }
#pragma unroll
            for (int db = 0; db < 2; ++db)
#pragma unroll
                for (int s = 0; s < 2; ++s) o[j][db] = __builtin_amdgcn_mfma_f32_32x32x16_bf16(vf[db][s], pf[s], o[j][db], 0, 0, 0);
        }
    }
#pragma unroll
    for (int j = 0; j < 2; ++j) { const float lo = ls[j] + __shfl_xor(ls[j], 32); const float inv = 1.0f / (lo + at_exp2(sink2 - mx[j]));
        const int qrel = 64 * rh + 32 * j + r32; bf16_t* op = qkvg + (size_t)(m0 + qrel) * QKVG_W + hq * 64 + 4 * hh;
#pragma unroll
        for (int db = 0; db < 2; ++db)
#pragma unroll
            for (int g = 0; g < 4; ++g) { cj_u32x2 w; w.x = pk2(o[j][db][4 * g] * inv, o[j][db][4 * g + 1] * inv); w.y = pk2(o[j][db][4 * g + 2] * inv, o[j][db][4 * g + 3] * inv);
                *(cj_u32x2*)(op + 32 * db + 8 * g) = w; } }
}

__global__ void __launch_bounds__(NTHR, 2) fwd_megakernel(Args args) {
    extern __shared__ __attribute__((aligned(16))) unsigned char lds[];
    Ctx C; C.tid = threadIdx.x; C.G = gridDim.x; C.bx = blockIdx.x; C.lds_g = lds;
    unsigned char* ws = args.ws;
    C.x_prompt = args.in[0]; C.x_sample = args.in[1]; C.emb_g = args.in[2]; C.emb_b = args.in[3]; C.w_in = args.in[4]; C.sink = args.in[5]; C.conv_w = args.in[6]; C.conv_b = args.in[7];
    C.fw1 = args.in[8]; C.fb1 = args.in[9]; C.ff1 = args.in[10]; C.fw2 = args.in[11]; C.fb2 = args.in[12]; C.ff2 = args.in[13]; C.fw3 = args.in[14]; C.fdec = args.in[15];
    C.hyd = args.in[16]; C.ang = args.in[17]; C.hng = args.in[18]; C.w_out = args.in[19]; C.lng = args.in[20]; C.lnb = args.in[21];
    C.dout = args.out; C.WIN = (bf16_t*)(ws + WS_WIN); C.WOUT = (bf16_t*)(ws + WS_WOUT); C.HB = (bf16_t*)(ws + WS_HB); C.QKVG = (bf16_t*)(ws + WS_QKVG);
    C.GH = (bf16_t*)(ws + WS_GH); C.HYT = (bf16_t*)(ws + WS_HYT); C.H2B = (bf16_t*)(ws + WS_SMALL); C.ROPE = (float*)(ws + WS_ROPE); C.WIN1 = (bf16_t*)(ws + WS_WIN1); C.WOUT1 = (bf16_t*)(ws + WS_WOUT1);
    C.UT0 = C.HB; C.UT1 = C.HB + (size_t)1024 * MTOK; C.ZT = C.HYT; C.A2 = C.HYT + (size_t)1024 * MTOK;
    LAS unsigned char* lds3 = (LAS unsigned char*)lds;
    for (int u = C.tid; u < (LDS_BYTES - LDSCTL_OFF) / 4; u += NTHR) ((LAS unsigned*)(lds3 + LDSCTL_OFF))[u] = 0u;
    __syncthreads();
    (void)xcd_barrier_post((unsigned*)(ws + WS_CTL) + CW_BAR, (volatile LAS unsigned*)(lds3 + MISC_OFF) + 8);
#define GRID_BAR() do { XcdBarrier bb_; bb_.bar = (unsigned*)(args.ws + WS_CTL) + CW_BAR; bb_.x = xb_xcc_id(); bb_.st = (volatile LAS unsigned*)(lds3 + MISC_OFF) + 8; xcd_barrier(bb_); } while (0)
#define H2P_(l) (C.H2B + (size_t)(l) * (size_t)(655360))
#define H2S_(l) (C.H2B + (size_t)(l) * (size_t)(655360) + (size_t)(524288))

    ph_ln_rows(C, C.x_prompt, C.x_sample, LP, C.emb_g, C.emb_b, C.dout, C.HB);
    ph_rope_table(C);
    ph_transpose(C, C.w_in, C.WIN, DMOD, DIN);
    ph_transpose(C, C.w_out, C.WOUT, DMOD, DMOD);
    ph_transpose(C, C.w_in + (size_t)DMOD * DIN, C.WIN1, DMOD, DIN);
    ph_transpose(C, C.w_out + (size_t)DMOD * DMOD, C.WOUT1, DMOD, DMOD);
    for (int l = 0; l < 2; ++l) { ph_filt_h2(C, l, H2P_(l), LP); ph_filt_h2(C, l, H2S_(l), LS); }
    GRID_BAR();
#pragma unroll 1
    for (int l = 0; l < 2; ++l) {
        { pg8::Gemm g{C.HB, l == 0 ? C.WIN : C.WIN1, MTOK, DIN, DMOD}; pg8::StaticOrder S; S.init(MTOK, DIN, C.G, C.bx);
          pg8::EpiIn E{C.QKVG, C.GH, C.HYT};
          pg8::gemm_phase<pg8::EpiIn, pg8::StaticOrder, true, true>(lds3, g, S, E); }
        GRID_BAR();
        for (int grp = C.bx; grp < 256; grp += C.G) conv_job<16, 1, 1>(C, l, grp, lds3, H2P_(l), 0);
        for (int grp = C.bx; grp < 256; grp += C.G) conv_job<4, 4, 2>(C, l, grp, lds3, H2S_(l), LP);
        for (int item = C.bx; item < 768; item += C.G) attn_item(C, C.sink + l * 16, item, lds3);
        GRID_BAR();
        ph_norm_gate(C, l);
        GRID_BAR();
        { pg8::Gemm g{C.A2, l == 0 ? C.WOUT : C.WOUT1, MTOK, DMOD, DMOD}; pg8::StaticOrder S; S.init(MTOK, DMOD, C.G, C.bx);
          pg8::EpiOut E{C.dout};
          pg8::gemm_phase<pg8::EpiOut, pg8::StaticOrder, true, true>(lds3, g, S, E); }
        GRID_BAR();
        ph_ln_rows(C, C.dout, C.dout, MTOK, C.lng + l * DMOD, C.lnb + l * DMOD, C.dout, C.HB);
        if (l == 0) GRID_BAR();
    }
}

extern "C" void kernel_launch(void* const* d_in, const int* in_sizes, int n_in, void* d_out, int out_size, void* d_ws, size_t ws_size, hipStream_t stream) {
    static int grid = 0;
    if (grid == 0) {
        if (n_in != 22 || out_size != MTOK * DMOD || ws_size < WS_END) { fprintf(stderr, "kernel_launch: unexpected shapes or workspace (%d inputs, out %d, ws %zu)\n", n_in, out_size, ws_size); grid = -1; return; }
        int dev = 0, cus = 0;
        if (hipGetDevice(&dev) != hipSuccess || hipDeviceGetAttribute(&cus, hipDeviceAttributeMultiprocessorCount, dev) != hipSuccess) { grid = -1; return; }
        if (hipFuncSetAttribute((const void*)fwd_megakernel, hipFuncAttributeMaxDynamicSharedMemorySize, LDS_BYTES) != hipSuccess) { fprintf(stderr, "kernel_launch: hipFuncSetAttribute failed\n"); grid = -1; return; }
        grid = cus;
    }
    if (grid < 0) return;
    if (hipMemsetAsync((char*)d_ws + WS_CTL, 0, CTL_ZERO_BYTES, stream) != hipSuccess) return;
    Args a{};
    for (int i = 0; i < 22; ++i) a.in[i] = (const float*)d_in[i];
    a.out = (float*)d_out; a.ws = (unsigned char*)d_ws;
    hipLaunchKernelGGL(fwd_megakernel, dim3(grid), dim3(NTHR), LDS_BYTES, stream, a);
}
```

```cpp
#include <hip/hip_runtime.h>
#include <cstdio>
#include <cstdint>
namespace pg8 {
#define PG8_LAS __attribute__((address_space(3)))
typedef unsigned short bf16_t;
typedef short bf16x8 __attribute__((ext_vector_type(8)));
typedef float f32x4 __attribute__((ext_vector_type(4)));
typedef unsigned u32x4 __attribute__((ext_vector_type(4)));
constexpr int BM = 256, BK = 64, HALF = 128, HTB = HALF * BK * 2  , STAGE_BYTES = 8 * HTB, NXCD = 8, WGM = 8;

__host__ __device__ __forceinline__ int lds_byte(int r, int c) { const int st = (r >> 4) * 2 + (c >> 5), rr = r & 15, cc = c & 31, ob = rr * 64 + cc * 2; return st * 1024 + (ob ^ (((ob >> 9) & 1) << 5)); }
__host__ __device__ __forceinline__ void stage_rc(int b, int& R, int& C) { const int st = b / 1024, sb = b % 1024, swz = sb ^ (((sb >> 9) & 1) << 5); R = (st >> 1) * 16 + swz / 64; C = (st & 1) * 32 + (swz % 64) / 2; }
__host__ __device__ __forceinline__ int perm32(int rho) { const int n = rho >> 4, i = rho & 15; return 8 * (i >> 2) + 4 * n + (i & 3); }

struct Unit { int pm, pn; };
struct Gemm { const bf16_t* A; const bf16_t* Bt; int M, N, K; };

struct StaticOrder {
    int nM, nN, nwg, G, c;
    __host__ __device__ void init(int M, int N, int G_, int c_) { nM = M / BM; nN = N / BM; nwg = nM * nN; G = G_; c = c_; }
    __host__ __device__ bool next(int i, Unit& u) const {
        const long L = (long)i * G + c; if (L >= nwg) return false;
        int wgid = (int)L; { const int q = nwg / NXCD, r = nwg % NXCD, xcd = wgid % NXCD, off = wgid / NXCD; wgid = (xcd < r ? xcd * (q + 1) : r * (q + 1) + (xcd - r) * q) + off; }
        const int nig = WGM * nN, gid = wgid / nig, fm = gid * WGM, gsz = (nM - fm) < WGM ? (nM - fm) : WGM;
        u.pm = fm + ((wgid % nig) % gsz); u.pn = (wgid % nig) / gsz; return true;
    }
    __device__ __forceinline__ void a_ready(const Unit&) const {}
    __device__ __forceinline__ void done(const Unit&) const {}
};

__device__ __forceinline__ unsigned cvt_pk_bf16(float lo, float hi) { unsigned r; asm volatile("v_cvt_pk_bf16_f32 %0, %1, %2" : "=v"(r) : "v"(lo), "v"(hi)); return r; }
typedef float f32x2 __attribute__((ext_vector_type(2)));
__device__ __forceinline__ f32x2 gelu_pk(f32x2 v) {
    const f32x2 av = __builtin_elementwise_abs(v), d = av * 0.2316418882f + 1.0f;
    f32x2 t; t.x = __builtin_amdgcn_rcpf(d.x); t.y = __builtin_amdgcn_rcpf(d.y);
    f32x2 q = t * 0.5307027145f + (-0.7265760135f); q = q * t + 0.7107068705f; q = q * t + (-0.142248368f); q = q * t + 0.127414796f; q = q * t;
    const f32x2 s = (v * v) * (-0.72134752044f);
    f32x2 e; e.x = __builtin_amdgcn_exp2f(s.x); e.y = __builtin_amdgcn_exp2f(s.y);
    const f32x2 m = v * (q * e), r = v - m;
    f32x2 o; o.x = v.x < 0.f ? m.x : r.x; o.y = v.y < 0.f ? m.y : r.y; return o;
}

template <int ACT  > struct EpiBf16 {
    static constexpr bool PERM = true, AFTER_DRAIN = false; static_assert(ACT == 0 || ACT == 1, "EpiBf16: ACT is 0 (none) or 1 (gelu_pk)");
    bf16_t* O; int ldc; const float* bias; int split_cols; size_t split_stride; float scale0;
    __device__ __forceinline__ void operator()(const f32x4 (&acc)[2][2][4][2], const Unit& u, int wr, int wc, int fr, int fq) const {
        const int row0 = u.pm * BM + wr * 64 + fr; int colt = u.pn * BM; bf16_t* base = O;
        float sc = 1.f; if (split_cols) { const int t = colt / split_cols; base += (size_t)t * split_stride; colt -= t * split_cols; if (t == 0) sc = scale0; }
        const int col0 = colt + wc * 32 + 8 * fq, bcol0 = u.pn * BM + wc * 32 + 8 * fq;
        f32x4 bv[2][2];
#pragma unroll
        for (int bj = 0; bj < 2; ++bj)
#pragma unroll
            for (int n = 0; n < 2; ++n) bv[bj][n] = bias ? *(const f32x4*)(bias + bcol0 + bj * HALF + 4 * n) : (f32x4){0.f, 0.f, 0.f, 0.f};
#pragma unroll
        for (int ai = 0; ai < 2; ++ai)
#pragma unroll
            for (int m = 0; m < 4; ++m) { bf16_t* rowp = base + (size_t)(row0 + ai * HALF + m * 16) * ldc + col0;
#pragma unroll
                for (int bj = 0; bj < 2; ++bj) { f32x4 v0 = acc[ai][bj][m][0] + bv[bj][0], v1 = acc[ai][bj][m][1] + bv[bj][1];
                    if (ACT == 1) { f32x2 a = gelu_pk((f32x2){v0[0], v0[1]}), b = gelu_pk((f32x2){v0[2], v0[3]}), c = gelu_pk((f32x2){v1[0], v1[1]}), d = gelu_pk((f32x2){v1[2], v1[3]});
                        v0 = (f32x4){a.x, a.y, b.x, b.y}; v1 = (f32x4){c.x, c.y, d.x, d.y}; }
                    v0 = v0 * sc; v1 = v1 * sc; u32x4 w; w.x = cvt_pk_bf16(v0[0], v0[1]); w.y = cvt_pk_bf16(v0[2], v0[3]); w.z = cvt_pk_bf16(v1[0], v1[1]); w.w = cvt_pk_bf16(v1[2], v1[3]);
                    *(u32x4*)(rowp + bj * HALF) = w; } }
    }
};

constexpr int MTOK = 24576, LP = 8192, LS = 2048, DMOD = 2048, DIN = 6656;
constexpr int QKVG_W = 2560;
constexpr float DN_ALPHA_F = 1.41421356237f;

__device__ __forceinline__ float silu_f(float x) { return x / (1.0f + __expf(-x)); }

struct EpiIn {
    static constexpr bool PERM = true, AFTER_DRAIN = false;
    bf16_t* qkvg; bf16_t* gh; bf16_t* hyt;
    __device__ __forceinline__ void operator()(const f32x4 (&acc)[2][2][4][2], const Unit& u, int wr, int wc, int fr, int fq) const {
        const int row0 = u.pm * BM + wr * 64 + fr; const int colt = u.pn * BM;
#pragma unroll
        for (int ai = 0; ai < 2; ++ai)
#pragma unroll
            for (int m = 0; m < 4; ++m) { const int row = row0 + ai * HALF + m * 16;
#pragma unroll
                for (int bj = 0; bj < 2; ++bj) { f32x4 v0 = acc[ai][bj][m][0], v1 = acc[ai][bj][m][1];
                    const int c0 = colt + bj * HALF + wc * 32 + 8 * fq;
                    if (colt < 2560) {
                        if (colt >= 1536) { for (int e = 0; e < 4; ++e) { v0[e] = silu_f(v0[e]); v1[e] = silu_f(v1[e]); } }
                        u32x4 w; w.x = cvt_pk_bf16(v0[0], v0[1]); w.y = cvt_pk_bf16(v0[2], v0[3]); w.z = cvt_pk_bf16(v1[0], v1[1]); w.w = cvt_pk_bf16(v1[2], v1[3]);
                        *(u32x4*)(qkvg + (size_t)row * QKVG_W + c0) = w;
                    } else if (colt < 5632) {
                        u32x4 w; w.x = cvt_pk_bf16(v0[0], v0[1]); w.y = cvt_pk_bf16(v0[2], v0[3]); w.z = cvt_pk_bf16(v1[0], v1[1]); w.w = cvt_pk_bf16(v1[2], v1[3]);
                        const int ch = c0 - 2560;
                        bf16_t* p = hyt + (size_t)ch * MTOK + row;
                        p[0] = (bf16_t)(w.x & 0xffff); p[(size_t)MTOK] = (bf16_t)(w.x >> 16); p[(size_t)2 * MTOK] = (bf16_t)(w.y & 0xffff); p[(size_t)3 * MTOK] = (bf16_t)(w.y >> 16);
                        p[(size_t)4 * MTOK] = (bf16_t)(w.z & 0xffff); p[(size_t)5 * MTOK] = (bf16_t)(w.z >> 16); p[(size_t)6 * MTOK] = (bf16_t)(w.w & 0xffff); p[(size_t)7 * MTOK] = (bf16_t)(w.w >> 16);
                    } else {
                        for (int e = 0; e < 4; ++e) { v0[e] = silu_f(v0[e]); v1[e] = silu_f(v1[e]); }
                        u32x4 w; w.x = cvt_pk_bf16(v0[0], v0[1]); w.y = cvt_pk_bf16(v0[2], v0[3]); w.z = cvt_pk_bf16(v1[0], v1[1]); w.w = cvt_pk_bf16(v1[2], v1[3]);
                        *(u32x4*)(gh + (size_t)row * 1024 + (c0 - 5632)) = w;
                    } } }
    }
};
struct EpiOut {
    static constexpr bool PERM = true, AFTER_DRAIN = false;
    float* dout;
    __device__ __forceinline__ void operator()(const f32x4 (&acc)[2][2][4][2], const Unit& u, int wr, int wc, int fr, int fq) const {
        const int row0 = u.pm * BM + wr * 64 + fr; const int colt = u.pn * BM;
#pragma unroll
        for (int ai = 0; ai < 2; ++ai)
#pragma unroll
            for (int m = 0; m < 4; ++m) { const int row = row0 + ai * HALF + m * 16;
#pragma unroll
                for (int bj = 0; bj < 2; ++bj) { const int c0 = colt + bj * HALF + wc * 32 + 8 * fq;
                    float* p = dout + (size_t)row * DMOD + c0;
                    f32x4 r0 = *(const f32x4*)p, r1 = *(const f32x4*)(p + 4);
                    r0 = r0 * DN_ALPHA_F + acc[ai][bj][m][0]; r1 = r1 * DN_ALPHA_F + acc[ai][bj][m][1];
                    *(f32x4*)p = r0; *(f32x4*)(p + 4) = r1; } }
    }
};
template <class Epi, class Sched, bool ALIGN_EPI = false, bool SP2 = false>
__device__ __forceinline__ void gemm_phase(PG8_LAS unsigned char* lds, const Gemm g, const Sched& S, const Epi& E) {
    int tid_o = threadIdx.x; asm volatile("" : "+v"(tid_o));
    const int tid = tid_o, wid = __builtin_amdgcn_readfirstlane(tid >> 6), lane = tid & 63, wr = wid >> 2, wc = wid & 3, fr = lane & 15, fq = lane >> 4;
    const int K = g.K, nt = K / BK;
    unsigned voffA[2], voffB[2];
#pragma unroll
    for (int i = 0; i < 2; ++i) { int R, C; stage_rc(tid * 16 + i * 8192, R, C); const int Rb = Epi::PERM ? ((R & ~31) + perm32(R & 31)) : R;
        voffA[i] = (unsigned)(R * K + C) * 2u; voffB[i] = (unsigned)(Rb * K + C) * 2u; }
    const size_t kstep = (size_t)(BK * 2);
    const size_t hstep = (size_t)HALF * K * 2;
    const size_t tstep = 2 * hstep;
    const unsigned ldsw = (unsigned)wid * 1024u;
    const int aoff = lds_byte(wr * 64 + fr, fq * 8), boff = lds_byte(wc * 32 + fr, fq * 8);
#define PG8_SA(b, h) (((b) * 2 + (h)) * HTB)
#define PG8_SB(b, h) ((4 + (b) * 2 + (h)) * HTB)
#define PG8_STAGE(bufoff, gbase, voff) do { _Pragma("unroll") for (int _i = 0; _i < 2; ++_i) \
        __builtin_amdgcn_global_load_lds((const unsigned*)((const char*)(gbase) + (voff)[_i]), (PG8_LAS unsigned*)(lds + (bufoff) + ldsw + _i * 8192), 16, 0, 0); } while (0)
#define PG8_LDA(dst, b, h) do { _Pragma("unroll") for (int m = 0; m < 4; ++m) _Pragma("unroll") for (int k = 0; k < 2; ++k) dst[m][k] = *(const PG8_LAS bf16x8*)(lds + PG8_SA(b, h) + aoff + m * 2048 + k * 1024); } while (0)
#define PG8_LDB(dst, b, h) do { _Pragma("unroll") for (int n = 0; n < 2; ++n) _Pragma("unroll") for (int k = 0; k < 2; ++k) dst[n][k] = *(const PG8_LAS bf16x8*)(lds + PG8_SB(b, h) + boff + n * 2048 + k * 1024); } while (0)
#define PG8_MMA(ai, bj, At, Bt) do { __builtin_amdgcn_s_setprio(1); _Pragma("unroll") for (int m = 0; m < 4; ++m) _Pragma("unroll") for (int n = 0; n < 2; ++n) _Pragma("unroll") for (int k = 0; k < 2; ++k) \
        acc[ai][bj][m][n] = __builtin_amdgcn_mfma_f32_16x16x32_bf16(Bt[n][k], At[m][k], acc[ai][bj][m][n], 0, 0, 0); __builtin_amdgcn_s_setprio(0); } while (0)
#define PG8_WAIT_V(n) asm volatile("s_waitcnt vmcnt(" #n ")" ::: "memory")
#define PG8_WAIT_L(n) asm volatile("s_waitcnt lgkmcnt(" #n ")" ::: "memory")
#define PG8_BAR __builtin_amdgcn_s_barrier()
#define PG8_SCHED __builtin_amdgcn_sched_barrier(0)
    Unit cur, nxt; int ui = 0;
    if (!S.next(0, cur)) return;
    f32x4 acc[2][2][4][2];
#pragma unroll
    for (int a = 0; a < 2; ++a)
#pragma unroll
        for (int b = 0; b < 2; ++b)
#pragma unroll
            for (int m = 0; m < 4; ++m)
#pragma unroll
                for (int n = 0; n < 2; ++n) acc[a][b][m][n] = (f32x4){0.f, 0.f, 0.f, 0.f};
    bf16x8 At[4][2], B0[2][2], B1[2][2];
    const char* cA = (const char*)g.A + (size_t)cur.pm * tstep; const char* cB = (const char*)g.Bt + (size_t)cur.pn * tstep;
    S.a_ready(cur);
    if constexpr (SP2) {
        PG8_STAGE(PG8_SB(0, 0), cB, voffB); PG8_STAGE(PG8_SB(0, 1), cB + hstep, voffB); PG8_STAGE(PG8_SA(0, 0), cA, voffA); PG8_STAGE(PG8_SA(0, 1), cA + hstep, voffA);
        if (wr == 1) PG8_BAR;
        PG8_WAIT_V(2); PG8_BAR;
        PG8_STAGE(PG8_SB(1, 0), cB + kstep, voffB); PG8_STAGE(PG8_SA(1, 0), cA + kstep, voffA); PG8_STAGE(PG8_SB(1, 1), cB + hstep + kstep, voffB);
        PG8_WAIT_V(6); PG8_BAR;
    } else {
        PG8_STAGE(PG8_SB(0, 0), cB, voffB); PG8_STAGE(PG8_SA(0, 0), cA, voffA); PG8_STAGE(PG8_SB(0, 1), cB + hstep, voffB); PG8_STAGE(PG8_SA(0, 1), cA + hstep, voffA);
        if (wr == 1) PG8_BAR;
        PG8_WAIT_V(4); PG8_BAR;
        PG8_STAGE(PG8_SB(1, 0), cB + kstep, voffB); PG8_STAGE(PG8_SA(1, 0), cA + kstep, voffA); PG8_STAGE(PG8_SB(1, 1), cB + hstep + kstep, voffB);
        PG8_WAIT_V(6); PG8_BAR;
    }
    for (;;) {
        const bool has_next = S.next(ui + 1, nxt);
        const char* nA = has_next ? (const char*)g.A + (size_t)nxt.pm * tstep : cA; const char* nB = has_next ? (const char*)g.Bt + (size_t)nxt.pn * tstep : cB;
        for (int t = 0; t < nt; t += 2) {
            const bool last = (t == nt - 2);
            const char* a1 = cA + (size_t)(t + 1) * kstep;
            const char* a2 = last ? nA : cA + (size_t)(t + 2) * kstep; const char* b2 = last ? nB : cB + (size_t)(t + 2) * kstep;
            const char* a3 = a2 + kstep; const char* b3 = b2 + kstep;
            if (last && has_next) S.a_ready(nxt);
            if constexpr (SP2) {
            PG8_LDB(B0, 0, 0); PG8_LDB(B1, 0, 1); PG8_SCHED; PG8_LDA(At, 0, 0); PG8_STAGE(PG8_SA(1, 1), a1 + hstep, voffA);
            PG8_WAIT_V(8); PG8_WAIT_L(0); PG8_BAR; PG8_MMA(0, 0, At, B0); PG8_MMA(0, 1, At, B1); PG8_BAR; PG8_SCHED;
            PG8_LDA(At, 0, 1); PG8_STAGE(PG8_SB(0, 0), b2, voffB); PG8_STAGE(PG8_SB(0, 1), b2 + hstep, voffB); PG8_STAGE(PG8_SA(0, 0), a2, voffA);
            PG8_WAIT_V(8); PG8_WAIT_L(0); PG8_BAR; PG8_MMA(1, 0, At, B0); PG8_MMA(1, 1, At, B1); PG8_BAR; PG8_SCHED;
            PG8_LDB(B0, 1, 0); PG8_LDB(B1, 1, 1); PG8_SCHED; PG8_LDA(At, 1, 0); PG8_STAGE(PG8_SA(0, 1), a2 + hstep, voffA);
            PG8_WAIT_V(8); PG8_WAIT_L(0); PG8_BAR; PG8_MMA(0, 0, At, B0); PG8_MMA(0, 1, At, B1); PG8_BAR; PG8_SCHED;
            PG8_LDA(At, 1, 1); PG8_STAGE(PG8_SB(1, 0), b3, voffB); PG8_STAGE(PG8_SB(1, 1), b3 + hstep, voffB); PG8_STAGE(PG8_SA(1, 0), a3, voffA);
            PG8_WAIT_V(8); PG8_WAIT_L(0); PG8_BAR; PG8_MMA(1, 0, At, B0); PG8_MMA(1, 1, At, B1); PG8_BAR; PG8_SCHED;
            } else {
            PG8_LDB(B0, 0, 0); PG8_SCHED; PG8_LDA(At, 0, 0); PG8_STAGE(PG8_SA(1, 1), a1 + hstep, voffA);
            PG8_WAIT_L(8); PG8_BAR; PG8_WAIT_L(0); PG8_MMA(0, 0, At, B0); PG8_BAR; PG8_SCHED;
            PG8_LDB(B1, 0, 1); PG8_STAGE(PG8_SB(0, 0), b2, voffB);
            PG8_BAR; PG8_WAIT_L(0); PG8_MMA(0, 1, At, B1); PG8_BAR;
            PG8_LDA(At, 0, 1); PG8_STAGE(PG8_SA(0, 0), a2, voffA);
            PG8_BAR; PG8_WAIT_L(0); PG8_MMA(1, 0, At, B0); PG8_BAR; PG8_SCHED;
            PG8_STAGE(PG8_SB(0, 1), b2 + hstep, voffB);
            PG8_WAIT_V(6); PG8_BAR; PG8_MMA(1, 1, At, B1); PG8_BAR;
            PG8_LDB(B0, 1, 0); PG8_SCHED; PG8_LDA(At, 1, 0); PG8_STAGE(PG8_SA(0, 1), a2 + hstep, voffA);
            PG8_WAIT_L(8); PG8_BAR; PG8_WAIT_L(0); PG8_MMA(0, 0, At, B0); PG8_BAR; PG8_SCHED;
            PG8_LDB(B1, 1, 1); PG8_STAGE(PG8_SB(1, 0), b3, voffB);
            PG8_BAR; PG8_WAIT_L(0); PG8_MMA(0, 1, At, B1); PG8_BAR;
            PG8_LDA(At, 1, 1); PG8_STAGE(PG8_SA(1, 0), a3, voffA);
            PG8_BAR; PG8_WAIT_L(0); PG8_MMA(1, 0, At, B0); PG8_BAR; PG8_SCHED;
            PG8_STAGE(PG8_SB(1, 1), b3 + hstep, voffB);
            PG8_WAIT_V(6); PG8_BAR; PG8_MMA(1, 1, At, B1); PG8_BAR;
            }
        }
        if constexpr (ALIGN_EPI) { if (wr == 0) PG8_BAR; }
        if constexpr (!Epi::AFTER_DRAIN) { E(acc, cur, wr, wc, fr, fq); S.done(cur); }
        if (!has_next) break;
#pragma unroll
        for (int a = 0; a < 2; ++a)
#pragma unroll
            for (int b = 0; b < 2; ++b)
#pragma unroll
                for (int m = 0; m < 4; ++m)
#pragma unroll
                    for (int n = 0; n < 2; ++n) acc[a][b][m][n] = (f32x4){0.f, 0.f, 0.f, 0.f};
        cur = nxt; cA = nA; cB = nB; ++ui;
        if constexpr (ALIGN_EPI) { if (wr == 1) PG8_BAR; }
    }
    PG8_WAIT_V(0);
    if constexpr (!ALIGN_EPI) { if (wr == 0) PG8_BAR; }
    PG8_BAR;
    if constexpr (Epi::AFTER_DRAIN) { E.fused(acc, cur, wr, wc, fr, fq, lds, wid, lane); S.done(cur); }
#undef PG8_SA
#undef PG8_SB
#undef PG8_STAGE
#undef PG8_LDA
#undef PG8_LDB
#undef PG8_MMA
#undef PG8_WAIT_V
#undef PG8_WAIT_L
#undef PG8_BAR
#undef PG8_SCHED
}
}
#define GAS __attribute__((address_space(1)))
#define LAS __attribute__((address_space(3)))
typedef unsigned short bf16;
typedef unsigned v4u __attribute__((ext_vector_type(4)));
typedef float f32x4 __attribute__((ext_vector_type(4)));
typedef short bf16x8 __attribute__((ext_vector_type(8)));
typedef GAS unsigned gu32;
typedef GAS unsigned long long gu64;
#define RLX_AGENT __ATOMIC_RELAXED, __HIP_MEMORY_SCOPE_AGENT
#define LDS_WAIT() asm volatile("s_waitcnt lgkmcnt(0)" ::: "memory")
#define VM_WAIT() asm volatile("s_waitcnt vmcnt(0)" ::: "memory")
__device__ __forceinline__ unsigned long long rt() { return __builtin_amdgcn_s_memrealtime(); }
__device__ __forceinline__ unsigned f2bf(float f) { unsigned u = __builtin_bit_cast(unsigned, f); return (u + 0x7fffu + ((u >> 16) & 1u)) >> 16; }
__device__ __forceinline__ unsigned pk2(float lo, float hi) { return f2bf(lo) | (f2bf(hi) << 16); }

#define XB_TMO      128
#define XB_XCNT(j)  (256  + 64 * (j))
#define XB_XSUB(j)  (1280 + 64 * (j))
#define XB_XGEN(j)  (2304 + 64 * (j))
#define XB_TOP      3328
#define XB_TOPGEN   3392
#define XCD_BAR_WORDS 3456
#define XB_SPIN_CAP (1u << 18)

__device__ __forceinline__ unsigned xb_ld(unsigned* p)              { return __hip_atomic_load(p, __ATOMIC_RELAXED, __HIP_MEMORY_SCOPE_AGENT); }
__device__ __forceinline__ unsigned xb_add(unsigned* p, unsigned v) { return __hip_atomic_fetch_add(p, v, __ATOMIC_RELAXED, __HIP_MEMORY_SCOPE_AGENT); }
__device__ __forceinline__ unsigned xb_xcc_id() { return (unsigned)__builtin_amdgcn_s_getreg((3 << 11) | 20) & 0xFu; }
#define XB_SPIN(cond, bar) do { unsigned _sp = 0; while (cond) { __builtin_amdgcn_s_sleep(1); \
    if ((++_sp & 255u) == 0u) { if (xb_ld(&(bar)[XB_TMO])) break; if (_sp > XB_SPIN_CAP) { atomicAdd(&(bar)[XB_TMO], 1u); break; } } } } while (0)

struct XcdBarrier {
    unsigned* bar; unsigned x;
    volatile LAS unsigned* st;
};

__device__ __forceinline__ XcdBarrier xcd_barrier_post(unsigned* bar, volatile LAS unsigned* st) {
    XcdBarrier b; b.bar = bar; b.x = xb_xcc_id(); b.st = st;
    if (threadIdx.x == 0) (void)xb_add(&bar[XB_XCNT(b.x)], 1u);
    return b;
}
__device__ __forceinline__ void xcd_barrier_complete(unsigned* bar, unsigned x, unsigned& nloc, unsigned& nx) {
    const unsigned G = gridDim.x * gridDim.y * gridDim.z;
    unsigned sum, cnt, mine, sp = 0u;
    for (;;) {
        sum = 0u; cnt = 0u; mine = 0u;
#pragma unroll
        for (unsigned j = 0; j < 16; ++j) { const unsigned c = xb_ld(&bar[XB_XCNT(j)]); sum += c; cnt += (c > 0u) ? 1u : 0u; mine = (j == x) ? c : mine; }
        if (sum == G) break;
        __builtin_amdgcn_s_sleep(1);
        if ((++sp & 255u) == 0u) { if (xb_ld(&bar[XB_TMO])) break; if (sp > XB_SPIN_CAP) { atomicAdd(&bar[XB_TMO], 1u); break; } }
    }
    nloc = mine > 0u ? mine : 1u; nx = cnt > 0u ? cnt : 1u;
}

__device__ __forceinline__ void xcd_barrier(const XcdBarrier& b) {
    asm volatile("s_waitcnt vmcnt(0)" ::: "memory");
    __syncthreads();
    if (threadIdx.x == 0) {
        unsigned* bar = b.bar;
        __builtin_amdgcn_s_waitcnt(0);
        unsigned nloc = b.st[0], nx = b.st[1];
        if (nloc == 0u) { xcd_barrier_complete(bar, b.x, nloc, nx); b.st[0] = nloc; b.st[1] = nx; }
        const unsigned old = xb_add(&bar[XB_XSUB(b.x)], 1u);
        const unsigned gen = old / nloc;
        if (old + 1u == (gen + 1u) * nloc) {
            __builtin_amdgcn_fence(__ATOMIC_RELEASE, "agent");
            asm volatile("s_waitcnt vmcnt(0)" ::: "memory");
            const unsigned og = xb_add(&bar[XB_TOP], 1u);
            const unsigned tg = og / nx;
            if (og + 1u == (tg + 1u) * nx) xb_add(&bar[XB_TOPGEN], 1u);
            else XB_SPIN(xb_ld(&bar[XB_TOPGEN]) == tg, bar);
            __builtin_amdgcn_fence(__ATOMIC_ACQUIRE, "agent");
            xb_add(&bar[XB_XGEN(b.x)], 1u);
            asm volatile("s_waitcnt vmcnt(0)" ::: "memory");
        } else {
            XB_SPIN(xb_ld(&bar[XB_XGEN(b.x)]) == gen, bar);
            __builtin_amdgcn_fence(__ATOMIC_ACQUIRE, "agent");
            asm volatile("s_waitcnt vmcnt(0)" ::: "memory");
        }
    }
    __syncthreads();
}

using pg8::bf16_t; using pg8::MTOK; using pg8::LP; using pg8::LS; using pg8::DMOD; using pg8::DIN; using pg8::QKVG_W;
typedef unsigned u32x4_t __attribute__((ext_vector_type(4)));
typedef float f32x4_t __attribute__((ext_vector_type(4)));
typedef unsigned cj_u32x2 __attribute__((ext_vector_type(2)));
__device__ __forceinline__ float bf2f(unsigned short b) { return __uint_as_float(((unsigned)b) << 16); }

constexpr size_t MiB = 1u << 20;
constexpr size_t WS_CTL = 0, CTL_ZERO_BYTES = 64 * 1024;
constexpr size_t WS_NRM = 512 * 1024;
constexpr size_t WS_WIN = 1 * MiB, WS_WOUT = 27 * MiB, WS_SMALL = 35 * MiB, WS_HB = 40 * MiB, WS_QKVG = 136 * MiB, WS_GH = 256 * MiB, WS_HYT = 304 * MiB, WS_WIN1 = 448 * MiB, WS_WOUT1 = 474 * MiB, WS_ROPE = 488 * MiB, WS_END = 489 * MiB;
constexpr int CW_BAR = 1024;
constexpr int RING_BYTES = 131072, LDSCTL_OFF = 159744, MISC_OFF = LDSCTL_OFF + 320, LDS_BYTES = 163840;
constexpr int NWAVES = 8, NTHR = 512;

struct Args { const float* in[22]; float* out; unsigned char* ws; };

struct Ctx {
    int tid; int G; int bx;
    unsigned char* lds_g;
    const float *x_prompt, *x_sample, *emb_g, *emb_b, *w_in, *sink, *conv_w, *conv_b, *fw1, *fb1, *ff1, *fw2, *fb2, *ff2, *fw3, *fdec, *hyd, *ang, *hng, *w_out, *lng, *lnb;
    float* dout; bf16_t *WIN, *WOUT, *WIN1, *WOUT1, *HB, *QKVG, *GH, *HYT, *UT0, *UT1, *ZT, *A2, *H2B; float *ROPE;
};
__device__ __forceinline__ void seq_of_row(int m, int& start, int& L, int& pos) {
    if (m < LP) { start = 0; L = LP; pos = m; } else { const int r = m - LP; start = LP + (r / LS) * LS; L = LS; pos = r % LS; }
}
#define OPAQUE_TID(t) int t = threadIdx.x; asm volatile("" : "+v"(t))
#define VB_SETUP(BS) OPAQUE_TID(otid_); const int per_ = NTHR / (BS); const int vsub = otid_ / (BS); const int vtid = otid_ % (BS); (void)vsub; (void)vtid; (void)per_
#define VB_FOR(nvb) for (int it_ = C.bx; it_ * per_ < (nvb); it_ += C.G)

__device__ __forceinline__ void ph_transpose(const Ctx& C, const float* W, bf16_t* WT, int K, int N) {
    VB_SETUP(256); float* t = (float*)C.lds_g + vsub * (32 * 33); const int nbx = N / 32, nvb = nbx * (K / 32);
    VB_FOR(nvb) { const int vb = it_ * per_ + vsub; const int n0 = (vb % nbx) * 32, k0 = (vb / nbx) * 32, tx = vtid & 31, ty = vtid >> 5;
        __syncthreads();
        for (int i = 0; i < 4; ++i) t[(ty + 8 * i) * 33 + tx] = W[(size_t)(k0 + ty + 8 * i) * N + n0 + tx];
        __syncthreads();
        for (int i = 0; i < 4; ++i) WT[(size_t)(n0 + ty + 8 * i) * K + k0 + tx] = (bf16_t)f2bf(t[tx * 33 + ty + 8 * i]); }
    __syncthreads();
}
__device__ __forceinline__ void ph_ln_rows(const Ctx& C, const float* in0, const float* in1, int split, const float* g, const float* b, float* outf, bf16_t* outb) {
    VB_SETUP(256); float* red = (float*)C.lds_g + vsub * 8;
    VB_FOR(MTOK) { const int m = it_ * per_ + vsub; const int tid = vtid;
        const float* src = (m < split) ? in0 + (size_t)m * DMOD : in1 + (size_t)(m - split) * DMOD;
        f32x4_t v0 = *(const f32x4_t*)(src + tid * 8), v1 = *(const f32x4_t*)(src + tid * 8 + 4);
        float s = (v0[0] + v0[1]) + (v0[2] + v0[3]) + (v1[0] + v1[1]) + (v1[2] + v1[3]);
        for (int o = 1; o < 64; o <<= 1) s += __shfl_xor(s, o);
        __syncthreads();
        if ((tid & 63) == 0) red[tid >> 6] = s;
        __syncthreads();
        const float mean = (red[0] + red[1] + red[2] + red[3]) * (1.0f / DMOD);
        v0 = v0 - mean; v1 = v1 - mean;
        float q = (v0[0] * v0[0] + v0[1] * v0[1]) + (v0[2] * v0[2] + v0[3] * v0[3]) + (v1[0] * v1[0] + v1[1] * v1[1]) + (v1[2] * v1[2] + v1[3] * v1[3]);
        for (int o = 1; o < 64; o <<= 1) q += __shfl_xor(q, o);
        if ((tid & 63) == 0) red[4 + (tid >> 6)] = q;
        __syncthreads();
        const float rstd = rsqrtf((red[4] + red[5] + red[6] + red[7]) * (1.0f / DMOD) + 1e-5f);
        const f32x4_t g0 = *(const f32x4_t*)(g + tid * 8), g1 = *(const f32x4_t*)(g + tid * 8 + 4), b0 = *(const f32x4_t*)(b + tid * 8), b1 = *(const f32x4_t*)(b + tid * 8 + 4);
        v0 = v0 * rstd * g0 + b0; v1 = v1 * rstd * g1 + b1;
        *(f32x4_t*)(outf + (size_t)m * DMOD + tid * 8) = v0; *(f32x4_t*)(outf + (size_t)m * DMOD + tid * 8 + 4) = v1;
        u32x4_t w; w.x = pk2(v0[0], v0[1]); w.y = pk2(v0[2], v0[3]); w.z = pk2(v1[0], v1[1]); w.w = pk2(v1[2], v1[3]);
        *(u32x4_t*)(outb + (size_t)m * DMOD + tid * 8) = w; }
    __syncthreads();
}
__device__ __forceinline__ void ph_rope_table(const Ctx& C) {
    OPAQUE_TID(otid_);
    for (int idx = C.bx * NTHR + otid_; idx < LP * 8; idx += C.G * NTHR) { const int pos = idx >> 3, i = idx & 7;
        const float inv = powf(500000.0f, -(float)(2 * i) / 16.0f); const float ang = (float)pos * inv;
        C.ROPE[pos * 16 + i] = cosf(ang); C.ROPE[pos * 16 + 8 + i] = sinf(ang); }
}
__device__ __forceinline__ void ph_filt_h2(const Ctx& C, int l, bf16_t* H2, int L) {
    VB_SETUP(64); float* z = (float*)C.lds_g + vsub * 128; float* h1 = z + 40;
    const float* w1 = C.fw1 + l * 33 * 64; const float* b1 = C.fb1 + l * 64; const float* f1 = C.ff1 + l * 64; const float* w2 = C.fw2 + l * 64 * 64; const float* b2 = C.fb2 + l * 64; const float* f2 = C.ff2 + l * 64;
    VB_FOR(L) { const int pos = it_ * per_ + vsub, j = vtid;
        __syncthreads();
        if (j < 33) { float v;
            if (j == 0) v = (float)pos / (float)(L - 1);
            else { const int k = (j - 1) & 15; const float band = 1e-4f + (float)k * ((15.0f - 1e-4f) / 15.0f);
                   const float w = 6.283185307179586f * (float)pos / (float)L; const float ang = w * band;
                   v = (j <= 16) ? cosf(ang) : -sinf(ang); }
            z[j] = v; }
        __syncthreads();
        float a = b1[j]; for (int i = 0; i < 33; ++i) a += z[i] * w1[i * 64 + j];
        h1[j] = sinf(f1[j] * a);
        __syncthreads();
        float c = b2[j]; for (int i = 0; i < 64; ++i) c += h1[i] * w2[i * 64 + j];
        H2[pos * 64 + j] = (bf16_t)f2bf(sinf(f2[j] * c)); }
    __syncthreads();
}
__device__ __forceinline__ void ph_norm_gate(const Ctx& C, int l, LAS unsigned char* lds3) {
    OPAQUE_TID(tid); const int lane = tid & 63, wid = __builtin_amdgcn_readfirstlane(tid >> 6);
    const float* ag = C.ang + l * 1024; const float* hg = C.hng + l * 1024;
    constexpr int PT = 2056;
    for (int item = C.bx; item < MTOK / 32; item += C.G) { const int m0 = item * 32;
        __syncthreads();
        for (int idx = tid; idx < 4096; idx += NTHR) { const int c = idx >> 2, tq = idx & 3;
            const u32x4_t w = *(const u32x4_t*)(C.ZT + (size_t)c * MTOK + m0 + 8 * tq);
            LAS unsigned char* p = lds3 + (8 * tq) * PT + 2 * c;
#pragma unroll
            for (int e = 0; e < 4; ++e) { *(LAS unsigned short*)(p + (2 * e) * PT) = (unsigned short)(w[e] & 0xffffu); *(LAS unsigned short*)(p + (2 * e + 1) * PT) = (unsigned short)(w[e] >> 16); } }
        asm volatile("s_waitcnt lgkmcnt(0)" ::: "memory");
        __syncthreads();
#pragma unroll 1
        for (int k = 0; k < 4; ++k) { const int t = 4 * wid + k, m = m0 + t;
            const bf16_t* ap = C.QKVG + (size_t)m * QKVG_W + 16 * lane;
            const u32x4_t a0 = *(const u32x4_t*)ap, a1 = *(const u32x4_t*)(ap + 8);
            const u32x4_t g0 = *(const u32x4_t*)(ap + 1536), g1 = *(const u32x4_t*)(ap + 1536 + 8);
            const LAS unsigned char* zp = lds3 + t * PT + 32 * lane;
            u32x4_t z0, z1; { const cj_u32x2 q0 = *(const LAS cj_u32x2*)zp, q1 = *(const LAS cj_u32x2*)(zp + 8), q2 = *(const LAS cj_u32x2*)(zp + 16), q3 = *(const LAS cj_u32x2*)(zp + 24); z0 = (u32x4_t){q0.x, q0.y, q1.x, q1.y}; z1 = (u32x4_t){q2.x, q2.y, q3.x, q3.y}; }
            const u32x4_t h0 = *(const u32x4_t*)(C.GH + (size_t)m * 1024 + 16 * lane), h1 = *(const u32x4_t*)(C.GH + (size_t)m * 1024 + 16 * lane + 8);
            float av[16], zv[16]; float sa = 0.f, sz = 0.f;
#pragma unroll
            for (int e = 0; e < 4; ++e) { av[2 * e] = __uint_as_float(a0[e] << 16); av[2 * e + 1] = __uint_as_float(a0[e] & 0xffff0000u); av[8 + 2 * e] = __uint_as_float(a1[e] << 16); av[9 + 2 * e] = __uint_as_float(a1[e] & 0xffff0000u);
                zv[2 * e] = __uint_as_float(z0[e] << 16); zv[2 * e + 1] = __uint_as_float(z0[e] & 0xffff0000u); zv[8 + 2 * e] = __uint_as_float(z1[e] << 16); zv[9 + 2 * e] = __uint_as_float(z1[e] & 0xffff0000u); }
#pragma unroll
            for (int e = 0; e < 16; ++e) { sa += av[e] * av[e]; sz += zv[e] * zv[e]; }
#pragma unroll
            for (int o = 1; o < 64; o <<= 1) { sa += __shfl_xor(sa, o); sz += __shfl_xor(sz, o); }
            const float ra = rsqrtf(sa * (1.0f / 1024.0f) + 1e-5f), rz = rsqrtf(sz * (1.0f / 1024.0f) + 1e-5f);
            float gav[16], ghv[16];
#pragma unroll
            for (int e = 0; e < 4; ++e) { gav[2 * e] = __uint_as_float(g0[e] << 16); gav[2 * e + 1] = __uint_as_float(g0[e] & 0xffff0000u); gav[8 + 2 * e] = __uint_as_float(g1[e] << 16); gav[9 + 2 * e] = __uint_as_float(g1[e] & 0xffff0000u);
                ghv[2 * e] = __uint_as_float(h0[e] << 16); ghv[2 * e + 1] = __uint_as_float(h0[e] & 0xffff0000u); ghv[8 + 2 * e] = __uint_as_float(h1[e] << 16); ghv[9 + 2 * e] = __uint_as_float(h1[e] & 0xffff0000u); }
            float wa[16], wz[16];
#pragma unroll
            for (int q = 0; q < 4; ++q) { const f32x4_t x = *(const f32x4_t*)(ag + 16 * lane + 4 * q), y = *(const f32x4_t*)(hg + 16 * lane + 4 * q);
#pragma unroll
                for (int e = 0; e < 4; ++e) { wa[4 * q + e] = x[e]; wz[4 * q + e] = y[e]; } }
            u32x4_t oa0, oa1, oz0, oz1;
#pragma unroll
            for (int e = 0; e < 4; ++e) { oa0[e] = pk2(av[2 * e] * ra * wa[2 * e] * gav[2 * e], av[2 * e + 1] * ra * wa[2 * e + 1] * gav[2 * e + 1]);
                oa1[e] = pk2(av[8 + 2 * e] * ra * wa[8 + 2 * e] * gav[8 + 2 * e], av[9 + 2 * e] * ra * wa[9 + 2 * e] * gav[9 + 2 * e]);
                oz0[e] = pk2(zv[2 * e] * rz * wz[2 * e] * ghv[2 * e], zv[2 * e + 1] * rz * wz[2 * e + 1] * ghv[2 * e + 1]);
                oz1[e] = pk2(zv[8 + 2 * e] * rz * wz[8 + 2 * e] * ghv[8 + 2 * e], zv[9 + 2 * e] * rz * wz[9 + 2 * e] * ghv[9 + 2 * e]); }
            bf16_t* op = C.A2 + (size_t)m * DMOD + 16 * lane;
            *(u32x4_t*)op = oa0; *(u32x4_t*)(op + 8) = oa1; *(u32x4_t*)(op + 1024) = oz0; *(u32x4_t*)(op + 1024 + 8) = oz1; }
    }
    __syncthreads();
}

typedef short cj_bf16x8 __attribute__((ext_vector_type(8)));
typedef float cj_f32x4 __attribute__((ext_vector_type(4)));

template <int NB16, int NSQ, int NPASS>
__device__ __forceinline__ void conv_job(const Ctx& C, int l, int grp, LAS unsigned char* lds3, const bf16_t* H2B, int seq_base0) {
    constexpr int L = NB16 * 512, NB = NB16 * 16, RLEN = 2 * L + 128, RC = L + 32, RBYTES = RLEN * 2;
    constexpr int NRM_OFF = 4 * RBYTES;
    static_assert(NRM_OFF + 8 * 8 * 4 + 16 <= LDSCTL_OFF, "conv job LDS");
    OPAQUE_TID(tid);
    const int lane = tid & 63, wid = __builtin_amdgcn_readfirstlane(tid >> 6), cc = wid & 3, mi = wid >> 2;
    const int r16 = lane & 15, g4 = lane >> 4;
    const int c0 = grp * 4, c = c0 + cc;
    const float* cw = C.conv_w + (size_t)l * 3 * 3072; const float* cb = C.conv_b + (size_t)l * 3072;
    LAS float* part = (LAS float*)(lds3 + NRM_OFF); LAS float* nrmv = part + 64;

    { constexpr int CH = NSQ * NPASS * L / 8;
      for (int idx = tid; idx < 4 * CH; idx += NTHR) { const int ch = idx / CH, q = idx % CH; const int cidx_ = c0 + ch;
          const int sq = q / (L / 8), t = (q % (L / 8)) * 8; const size_t off = (size_t)cidx_ * MTOK + seq_base0 + sq * L + t;
          const u32x4_t w = *(const u32x4_t*)(C.HYT + off);
          float h[10]; h[0] = t > 0 ? bf2f(C.HYT[off - 1]) : 0.f; h[9] = t + 8 < L ? bf2f(C.HYT[off + 8]) : 0.f;
#pragma unroll
          for (int e = 0; e < 4; ++e) { h[1 + 2 * e] = __uint_as_float(w[e] << 16); h[2 + 2 * e] = __uint_as_float(w[e] & 0xffff0000u); }
          const float w0 = cw[cidx_], w1 = cw[3072 + cidx_], w2 = cw[6144 + cidx_], bb = cb[cidx_];
          float o[8];
#pragma unroll
          for (int e = 0; e < 8; ++e) o[e] = h[e] * w0 + h[e + 1] * w1 + h[e + 2] * w2 + bb;
          u32x4_t ow; ow.x = pk2(o[0], o[1]); ow.y = pk2(o[2], o[3]); ow.z = pk2(o[4], o[5]); ow.w = pk2(o[6], o[7]);
          *(u32x4_t*)(C.UT0 + off) = ow; } }

#pragma unroll 1
    for (int order = 0; order < 2; ++order) {
        __syncthreads();
        {
          for (int idx = tid; idx < 4 * (33 + 96); idx += NTHR) { const int ch = idx / 129, q = idx % 129; const int x = q < 33 ? q : (2 * L + 32 + (q - 33));
              *(LAS unsigned short*)(lds3 + ch * RBYTES + 2 * x) = 0; }
          const float* w3 = C.fw3 + (size_t)l * 64 * 4096; const float* decay = C.fdec + (size_t)l * 4096;
          const int col = r16; const bool cv = col < 8; const int dir = (col >> 2) & 1, fch = col & 3;
          const int fidx = order * 2048 + dir * 1024 + c0 + fch;
          cj_bf16x8 Bw[2];
#pragma unroll
          for (int ks = 0; ks < 2; ++ks) { unsigned wv[4];
#pragma unroll
              for (int j = 0; j < 4; ++j) { const int k = 32 * ks + 8 * g4 + 2 * j; const float a = cv ? w3[(size_t)k * 4096 + fidx] : 0.f, b = cv ? w3[(size_t)(k + 1) * 4096 + fidx] : 0.f; wv[j] = pk2(a, b); }
              Bw[ks] = __builtin_bit_cast(cj_bf16x8, (u32x4_t){wv[0], wv[1], wv[2], wv[3]}); }
          const float kd = cv ? fabsf(decay[fidx]) * (1.4426950408889634f / (float)(L - 1)) : 0.f;
          float nacc = 0.f;
          LAS unsigned char* Rw = lds3 + fch * RBYTES;
          for (int mt = wid; mt < L / 16; mt += NWAVES) { const int p0 = mt * 16;
              const cj_bf16x8 A0 = *(const cj_bf16x8*)(H2B + (size_t)(p0 + r16) * 64 + 8 * g4), A1 = *(const cj_bf16x8*)(H2B + (size_t)(p0 + r16) * 64 + 32 + 8 * g4);
              cj_f32x4 d = {0.f, 0.f, 0.f, 0.f};
              d = __builtin_amdgcn_mfma_f32_16x16x32_bf16(A0, Bw[0], d, 0, 0, 0);
              d = __builtin_amdgcn_mfma_f32_16x16x32_bf16(A1, Bw[1], d, 0, 0, 0);
#pragma unroll
              for (int rg = 0; rg < 4; ++rg) { const int pos = p0 + 4 * g4 + rg; const float v = d[rg] * __builtin_amdgcn_exp2f(-(float)pos * kd);
                  nacc += fabsf(v);
                  const int x = dir ? RC + pos : RC - pos;
                  if (cv && !(dir && pos == 0)) *(LAS unsigned short*)(Rw + 2 * x) = (unsigned short)f2bf(v); } }
          nacc += __shfl_xor(nacc, 16); nacc += __shfl_xor(nacc, 32);
          if (lane < 8) { LAS float* pw = part + wid * 8 + lane; asm volatile("" : "+v"(pw)); pw[0] = nacc; } }
        asm volatile("s_waitcnt vmcnt(0) lgkmcnt(0)" ::: "memory");
        __syncthreads();
        if (tid < 4) { LAS float* pb = part + tid; asm volatile("" : "+v"(pb)); float s = 0.f; for (int w = 0; w < 8; ++w) s += pb[w * 8] + pb[w * 8 + 4]; pb[64] = s; }
        __syncthreads();
        float inv_n; { LAS float* pn = nrmv + cc; asm volatile("" : "+v"(pn)); inv_n = 1.0f / pn[0]; }
        const float dd = C.hyd[(size_t)l * 2048 + order * 1024 + c];
        const bf16_t* U = (order == 0 ? C.UT0 : C.UT1) + (size_t)c * MTOK;
        bf16_t* Zo = (order == 0 ? C.UT1 : C.ZT) + (size_t)c * MTOK;
        const int gc = 1024 * (order + 1) + c; const bf16_t* HG = C.HYT + (size_t)gc * MTOK;
        const float gw0 = cw[gc], gw1 = cw[3072 + gc], gw2 = cw[6144 + gc], gbb = cb[gc];
        const int xb = RC - 16 * mi - r16 + 8 * g4; const int par = xb & 1; const unsigned sh = (unsigned)par * 16u;
        const unsigned abase0 = (unsigned)(cc * RBYTES + 2 * (xb - par) - (NB16 - 1) * 1024);

#pragma unroll 1
        for (int pass = 0; pass < NPASS; ++pass) {
            const int sbase = seq_base0 + pass * NSQ * L;
            cj_f32x4 acc[NSQ][NB16];
#pragma unroll
            for (int sq = 0; sq < NSQ; ++sq)
#pragma unroll
                for (int n = 0; n < NB16; ++n) acc[sq][n] = (cj_f32x4){0.f, 0.f, 0.f, 0.f};
#pragma unroll 1
            for (int ff = 0; ff < 16; ++ff) { const int f = (ff + 8 * mi) & 15;
                cj_bf16x8 Bf[NSQ][NB16 + 1];
                const bf16_t* ub = U + sbase + 8 * g4 + 32 * (r16 - f);
#pragma unroll
                for (int sq = 0; sq < NSQ; ++sq)
#pragma unroll
                    for (int mp = 0; mp <= NB16; ++mp) { const int ab = 16 * mp + r16 - f;
                        if (mp == 0) { const bool ok = ab >= 0; cj_bf16x8 v = *(const cj_bf16x8*)(ub + sq * L + (ok ? 0 : 32 * f - 32 * r16)); if (!ok) v = (cj_bf16x8){0, 0, 0, 0, 0, 0, 0, 0}; Bf[sq][mp] = v; }
                        else if (mp == NB16) { const bool ok = ab < NB; cj_bf16x8 v = *(const cj_bf16x8*)(ub + sq * L + (ok ? 512 * NB16 : 0)); if (!ok) v = (cj_bf16x8){0, 0, 0, 0, 0, 0, 0, 0}; Bf[sq][mp] = v; }
                        else Bf[sq][mp] = *(const cj_bf16x8*)(ub + sq * L + 512 * mp); }
                const LAS unsigned* ap = (const LAS unsigned*)(lds3 + (abase0 - 64u * (unsigned)f));
                asm volatile("" : "+v"(ap));
                unsigned raw[2][5];
                { raw[0][0] = ap[0]; raw[0][1] = ap[1]; raw[0][2] = ap[2]; raw[0][3] = ap[3]; raw[0][4] = ap[4]; }
#pragma unroll
                for (int ei = 0; ei < 2 * NB16; ++ei) { const int e = NB16 - 1 - ei; const int cb_ = ei & 1, nb_ = cb_ ^ 1;
                    if (ei + 1 < 2 * NB16) { ap += 256; asm volatile("" : "+v"(ap)); raw[nb_][0] = ap[0]; raw[nb_][1] = ap[1]; raw[nb_][2] = ap[2]; raw[nb_][3] = ap[3]; raw[nb_][4] = ap[4]; }
                    u32x4_t aw; aw.x = __builtin_amdgcn_alignbit(raw[cb_][1], raw[cb_][0], sh); aw.y = __builtin_amdgcn_alignbit(raw[cb_][2], raw[cb_][1], sh);
                    aw.z = __builtin_amdgcn_alignbit(raw[cb_][3], raw[cb_][2], sh); aw.w = __builtin_amdgcn_alignbit(raw[cb_][4], raw[cb_][3], sh);
                    const cj_bf16x8 A = __builtin_bit_cast(cj_bf16x8, aw);
#pragma unroll
                    for (int sq = 0; sq < NSQ; ++sq)
#pragma unroll
                        for (int n = 0; n < NB16; ++n) { const int mp = n - e; if (mp >= 0 && mp <= NB16) acc[sq][n] = __builtin_amdgcn_mfma_f32_16x16x32_bf16(A, Bf[sq][mp], acc[sq][n], 0, 0, 0); }
                    __builtin_amdgcn_sched_barrier(0); }
            }
#pragma unroll
            for (int sq = 0; sq < NSQ; ++sq)
#pragma unroll
                for (int n = 0; n < NB16; ++n) { const int t0 = 32 * (16 * n + r16) + 16 * mi + 4 * g4; const size_t off = (size_t)sbase + sq * L + t0;
                    const cj_u32x2 uw = *(const cj_u32x2*)(U + off); const cj_u32x2 hw = *(const cj_u32x2*)(HG + off);
                    float h[6]; h[0] = (n > 0 || t0 > 0) ? bf2f(HG[off - 1]) : 0.f; h[5] = (n < NB16 - 1 || t0 + 4 < L) ? bf2f(HG[off + 4]) : 0.f;
                    h[1] = __uint_as_float(hw.x << 16); h[2] = __uint_as_float(hw.x & 0xffff0000u); h[3] = __uint_as_float(hw.y << 16); h[4] = __uint_as_float(hw.y & 0xffff0000u);
                    float uu[4] = {__uint_as_float(uw.x << 16), __uint_as_float(uw.x & 0xffff0000u), __uint_as_float(uw.y << 16), __uint_as_float(uw.y & 0xffff0000u)};
                    float z[4];
#pragma unroll
                    for (int j = 0; j < 4; ++j) { const float gate = h[j] * gw0 + h[j + 1] * gw1 + h[j + 2] * gw2 + gbb; z[j] = gate * (acc[sq][n][j] * inv_n + dd * uu[j]); }
                    cj_u32x2 ow; ow.x = pk2(z[0], z[1]); ow.y = pk2(z[2], z[3]);
                    *(cj_u32x2*)(Zo + off) = ow; __builtin_amdgcn_sched_barrier(0); }
        }
        asm volatile("s_waitcnt vmcnt(0)" ::: "memory");
    }
    __syncthreads();
}

typedef short at_bf16x8 __attribute__((ext_vector_type(8)));
typedef short at_s16x4 __attribute__((ext_vector_type(4)));
typedef float at_f32x16 __attribute__((ext_vector_type(16)));
constexpr int AT_VT_OFF = 49152, AT_VT_PITCH = 776;
__device__ __forceinline__ float at_exp2(float x) { return __builtin_amdgcn_exp2f(x); }

__device__ __forceinline__ void attn_item(const Ctx& C, const float* sinkp, int item, LAS unsigned char* lds3) {
    OPAQUE_TID(tid);
    const int lane = tid & 63, wid = __builtin_amdgcn_readfirstlane(tid >> 6), r32 = lane & 31, hh = lane >> 5;
    const int qblk = item >> 2, kv = item & 3; const int m0 = qblk * 128;
    int st, L, pos0; seq_of_row(m0, st, L, pos0);
    bf16_t* qkvg = C.QKVG;
    __syncthreads();
    for (int idx = tid; idx < 384 * 8; idx += NTHR) { const int key = idx >> 3, ch = idx & 7; const int pos = pos0 - 128 + key;
        if (pos < 0 || pos >= L) continue;
        const bf16_t* rowp = qkvg + (size_t)(st + pos) * QKVG_W + kv * 64;
        u32x4_t kw = *(const u32x4_t*)(rowp + 1024 + 8 * ch);
        if (ch < 2) { const u32x4_t ow = *(const u32x4_t*)(rowp + 1024 + 8 * (ch ^ 1));
            const f32x4_t c0 = *(const f32x4_t*)(C.ROPE + pos * 16), c1 = *(const f32x4_t*)(C.ROPE + pos * 16 + 4), s0 = *(const f32x4_t*)(C.ROPE + pos * 16 + 8), s1 = *(const f32x4_t*)(C.ROPE + pos * 16 + 12);
            const float cs[8] = {c0[0], c0[1], c0[2], c0[3], c1[0], c1[1], c1[2], c1[3]}, sn[8] = {s0[0], s0[1], s0[2], s0[3], s1[0], s1[1], s1[2], s1[3]};
            float o[8];
#pragma unroll
            for (int e = 0; e < 4; ++e) { const float a0 = __uint_as_float(kw[e] << 16), a1 = __uint_as_float(kw[e] & 0xffff0000u), b0 = __uint_as_float(ow[e] << 16), b1 = __uint_as_float(ow[e] & 0xffff0000u);
                o[2 * e] = ch == 0 ? a0 * cs[2 * e] - b0 * sn[2 * e] : a0 * cs[2 * e] + b0 * sn[2 * e];
                o[2 * e + 1] = ch == 0 ? a1 * cs[2 * e + 1] - b1 * sn[2 * e + 1] : a1 * cs[2 * e + 1] + b1 * sn[2 * e + 1]; }
            kw.x = pk2(o[0], o[1]); kw.y = pk2(o[2], o[3]); kw.z = pk2(o[4], o[5]); kw.w = pk2(o[6], o[7]); }
        *(LAS u32x4_t*)(lds3 + key * 128 + ((ch * 16) ^ ((key & 7) << 4))) = kw;
        const u32x4_t vw = *(const u32x4_t*)(rowp + 1280 + 8 * ch);
        LAS unsigned char* vt = lds3 + AT_VT_OFF + (8 * ch) * AT_VT_PITCH + key * 2;
#pragma unroll
        for (int e = 0; e < 4; ++e) { *(LAS unsigned short*)(vt + (2 * e) * AT_VT_PITCH) = (unsigned short)(vw[e] & 0xffffu); *(LAS unsigned short*)(vt + (2 * e + 1) * AT_VT_PITCH) = (unsigned short)(vw[e] >> 16); } }
    asm volatile("s_waitcnt vmcnt(0) lgkmcnt(0)" ::: "memory");
    __syncthreads();
    const int hq = kv * 4 + (wid >> 1), rh = wid & 1;
    const float sink2 = sinkp[hq] * 1.4426950408889634f;
    constexpr float C2 = 0.125f * 1.4426950408889634f;
    at_bf16x8 qf[2][4];
#pragma unroll
    for (int j = 0; j < 2; ++j) { const int qrel = 64 * rh + 32 * j + r32; const int pos = pos0 + qrel;
        const bf16_t* qp = qkvg + (size_t)(m0 + qrel) * QKVG_W + hq * 64;
#pragma unroll
        for (int s = 0; s < 4; ++s) { const u32x4_t w = *(const u32x4_t*)(qp + 16 * s + 8 * hh); float v[8];
#pragma unroll
            for (int e = 0; e < 4; ++e) { v[2 * e] = __uint_as_float(w[e] << 16); v[2 * e + 1] = __uint_as_float(w[e] & 0xffff0000u); }
            if (s == 0) { const u32x4_t ow = *(const u32x4_t*)(qp + 8 * (hh ^ 1));
                const f32x4_t c0 = *(const f32x4_t*)(C.ROPE + pos * 16), c1 = *(const f32x4_t*)(C.ROPE + pos * 16 + 4), s0 = *(const f32x4_t*)(C.ROPE + pos * 16 + 8), s1 = *(const f32x4_t*)(C.ROPE + pos * 16 + 12);
                const float cs[8] = {c0[0], c0[1], c0[2], c0[3], c1[0], c1[1], c1[2], c1[3]}, sn[8] = {s0[0], s0[1], s0[2], s0[3], s1[0], s1[1], s1[2], s1[3]};
#pragma unroll
                for (int e = 0; e < 4; ++e) { const float b0 = __uint_as_float(ow[e] << 16), b1 = __uint_as_float(ow[e] & 0xffff0000u);
                    v[2 * e] = hh == 0 ? v[2 * e] * cs[2 * e] - b0 * sn[2 * e] : v[2 * e] * cs[2 * e] + b0 * sn[2 * e];
                    v[2 * e + 1] = hh == 0 ? v[2 * e + 1] * cs[2 * e + 1] - b1 * sn[2 * e + 1] : v[2 * e + 1] * cs[2 * e + 1] + b1 * sn[2 * e + 1]; } }
            u32x4_t pw; pw.x = pk2(v[0] * C2, v[1] * C2); pw.y = pk2(v[2] * C2, v[3] * C2); pw.z = pk2(v[4] * C2, v[5] * C2); pw.w = pk2(v[6] * C2, v[7] * C2);
            qf[j][s] = __builtin_bit_cast(at_bf16x8, pw); } }
    at_f32x16 o[2][2];
#pragma unroll
    for (int j = 0; j < 2; ++j)
#pragma unroll
        for (int db = 0; db < 2; ++db)
#pragma unroll
            for (int r = 0; r < 16; ++r) o[j][db][r] = 0.f;
    float mx[2] = {sink2, sink2}, ls[2] = {0.f, 0.f};
    const LAS unsigned char* kbase = lds3 + r32 * 128; const int ksw = (r32 & 7);
    const LAS unsigned char* vbase = lds3 + AT_VT_OFF + r32 * AT_VT_PITCH + 8 * hh;
#pragma unroll 1
    for (int t = 0; t < 10; ++t) { const int kt = 2 * rh + t;
        const int kpos0 = pos0 - 128 + 32 * kt; if (kpos0 < 0 || kpos0 >= L) continue;
        at_bf16x8 kf[4];
#pragma unroll
        for (int s = 0; s < 4; ++s) kf[s] = *(const LAS at_bf16x8*)(kbase + kt * 4096 + (((2 * s + hh) ^ ksw) << 4));
        at_bf16x8 vf[2][2];
#pragma unroll
        for (int db = 0; db < 2; ++db)
#pragma unroll
            for (int s = 0; s < 2; ++s) { const LAS unsigned char* p = vbase + db * 32 * AT_VT_PITCH + (32 * kt + 16 * s) * 2;
                const at_s16x4 lo = *(const LAS at_s16x4*)p, hi = *(const LAS at_s16x4*)(p + 16);
                vf[db][s] = (at_bf16x8){lo[0], lo[1], lo[2], lo[3], hi[0], hi[1], hi[2], hi[3]}; }
#pragma unroll
        for (int j = 0; j < 2; ++j) {
            at_f32x16 sc;
#pragma unroll
            for (int r = 0; r < 16; ++r) sc[r] = 0.f;
#pragma unroll
            for (int s = 0; s < 4; ++s) sc = __builtin_amdgcn_mfma_f32_32x32x16_bf16(kf[s], qf[j][s], sc, 0, 0, 0);
            const int dq = (-128 + 32 * kt + 4 * hh) - (64 * rh + 32 * j + r32);
            float rm = -3.0e38f;
#pragma unroll
            for (int r = 0; r < 16; ++r) { const int dk = dq + (r & 3) + 8 * (r >> 2); const bool ok = (dk >= -128) && (dk <= 128); sc[r] = ok ? sc[r] : -3.0e38f; rm = fmaxf(rm, sc[r]); }
            { const float other = __shfl_xor(rm, 32); rm = fmaxf(rm, other); }
            if (__any(rm > mx[j])) { const float mn = fmaxf(mx[j], rm); const float al = at_exp2(mx[j] - mn); mx[j] = mn; ls[j] *= al;
#pragma unroll
                for (int db = 0; db < 2; ++db)
#pragma unroll
                    for (int r = 0; r < 16; ++r) o[j][db][r] *= al; }
            float psum = 0.f;
#pragma unroll
            for (int r = 0; r < 16; ++r) { sc[r] = at_exp2(sc[r] - mx[j]); psum += sc[r]; }
            ls[j] += psum;
            at_bf16x8 pf[2];
#pragma unroll
            for (int s = 0; s < 2; ++s) { u32x4_t pw; pw.x = pk2(sc[8 * s], sc[8 * s + 1]); pw.y = pk2(sc[8 * s + 2], sc[8 * s + 3]); pw.z = pk2(sc[8 * s + 4], sc[8 * s + 5]); pw.w = pk2(sc[8 * s + 6], sc[8 * s + 7]);
                pf[s] = __builtin_bit_cast(at_bf16x8, pw); }
#pragma unroll
            for (int db = 0; db < 2; ++db)
#pragma unroll
                for (int s = 0; s < 2; ++s) o[j][db] = __builtin_amdgcn_mfma_f32_32x32x16_bf16(vf[db][s], pf[s], o[j][db], 0, 0, 0);
        }
    }
#pragma unroll
    for (int j = 0; j < 2; ++j) { const float lo = ls[j] + __shfl_xor(ls[j], 32); const float inv = 1.0f / (lo + at_exp2(sink2 - mx[j]));
        const int qrel = 64 * rh + 32 * j + r32; bf16_t* op = qkvg + (size_t)(m0 + qrel) * QKVG_W + hq * 64 + 4 * hh;
#pragma unroll
        for (int db = 0; db < 2; ++db)
#pragma unroll
            for (int g = 0; g < 4; ++g) { cj_u32x2 w; w.x = pk2(o[j][db][4 * g] * inv, o[j][db][4 * g + 1] * inv); w.y = pk2(o[j][db][4 * g + 2] * inv, o[j][db][4 * g + 3] * inv);
                *(cj_u32x2*)(op + 32 * db + 8 * g) = w; } }
}

__global__ void __launch_bounds__(NTHR, 2) fwd_megakernel(Args args) {
    extern __shared__ __attribute__((aligned(16))) unsigned char lds[];
    Ctx C; C.tid = threadIdx.x; C.G = gridDim.x; C.bx = blockIdx.x; C.lds_g = lds;
    unsigned char* ws = args.ws;
    C.x_prompt = args.in[0]; C.x_sample = args.in[1]; C.emb_g = args.in[2]; C.emb_b = args.in[3]; C.w_in = args.in[4]; C.sink = args.in[5]; C.conv_w = args.in[6]; C.conv_b = args.in[7];
    C.fw1 = args.in[8]; C.fb1 = args.in[9]; C.ff1 = args.in[10]; C.fw2 = args.in[11]; C.fb2 = args.in[12]; C.ff2 = args.in[13]; C.fw3 = args.in[14]; C.fdec = args.in[15];
    C.hyd = args.in[16]; C.ang = args.in[17]; C.hng = args.in[18]; C.w_out = args.in[19]; C.lng = args.in[20]; C.lnb = args.in[21];
    C.dout = args.out; C.WIN = (bf16_t*)(ws + WS_WIN); C.WOUT = (bf16_t*)(ws + WS_WOUT); C.HB = (bf16_t*)(ws + WS_HB); C.QKVG = (bf16_t*)(ws + WS_QKVG);
    C.GH = (bf16_t*)(ws + WS_GH); C.HYT = (bf16_t*)(ws + WS_HYT); C.H2B = (bf16_t*)(ws + WS_SMALL); C.ROPE = (float*)(ws + WS_ROPE); C.WIN1 = (bf16_t*)(ws + WS_WIN1); C.WOUT1 = (bf16_t*)(ws + WS_WOUT1);
    C.UT0 = C.HB; C.UT1 = C.HB + (size_t)1024 * MTOK; C.ZT = C.HYT; C.A2 = C.HYT + (size_t)1024 * MTOK;
    LAS unsigned char* lds3 = (LAS unsigned char*)lds;
    for (int u = C.tid; u < (LDS_BYTES - LDSCTL_OFF) / 4; u += NTHR) ((LAS unsigned*)(lds3 + LDSCTL_OFF))[u] = 0u;
    __syncthreads();
    (void)xcd_barrier_post((unsigned*)(ws + WS_CTL) + CW_BAR, (volatile LAS unsigned*)(lds3 + MISC_OFF) + 8);
#define GRID_BAR() do { XcdBarrier bb_; bb_.bar = (unsigned*)(args.ws + WS_CTL) + CW_BAR; bb_.x = xb_xcc_id(); bb_.st = (volatile LAS unsigned*)(lds3 + MISC_OFF) + 8; xcd_barrier(bb_); } while (0)
#define H2P_(l) (C.H2B + (size_t)(l) * (size_t)(655360))
#define H2S_(l) (C.H2B + (size_t)(l) * (size_t)(655360) + (size_t)(524288))

    ph_ln_rows(C, C.x_prompt, C.x_sample, LP, C.emb_g, C.emb_b, C.dout, C.HB);
    ph_rope_table(C);
    ph_transpose(C, C.w_in, C.WIN, DMOD, DIN);
    ph_transpose(C, C.w_out, C.WOUT, DMOD, DMOD);
    ph_transpose(C, C.w_in + (size_t)DMOD * DIN, C.WIN1, DMOD, DIN);
    ph_transpose(C, C.w_out + (size_t)DMOD * DMOD, C.WOUT1, DMOD, DMOD);
    for (int l = 0; l < 2; ++l) { ph_filt_h2(C, l, H2P_(l), LP); ph_filt_h2(C, l, H2S_(l), LS); }
    GRID_BAR();
#pragma unroll 1
    for (int l = 0; l < 2; ++l) {
        { pg8::Gemm g{C.HB, l == 0 ? C.WIN : C.WIN1, MTOK, DIN, DMOD}; pg8::StaticOrder S; S.init(MTOK, DIN, C.G, C.bx);
          pg8::EpiIn E{C.QKVG, C.GH, C.HYT};
          pg8::gemm_phase<pg8::EpiIn, pg8::StaticOrder, true, true>(lds3, g, S, E); }
        GRID_BAR();
        for (int grp = C.bx; grp < 256; grp += C.G) conv_job<16, 1, 1>(C, l, grp, lds3, H2P_(l), 0);
        for (int grp = C.bx; grp < 256; grp += C.G) conv_job<4, 4, 2>(C, l, grp, lds3, H2S_(l), LP);
        for (int item = C.bx; item < 768; item += C.G) attn_item(C, C.sink + l * 16, item, lds3);
        GRID_BAR();
        ph_norm_gate(C, l, lds3);
        GRID_BAR();
        { pg8::Gemm g{C.A2, l == 0 ? C.WOUT : C.WOUT1, MTOK, DMOD, DMOD}; pg8::StaticOrder S; S.init(MTOK, DMOD, C.G, C.bx);
          pg8::EpiOut E{C.dout};
          pg8::gemm_phase<pg8::EpiOut, pg8::StaticOrder, true, true>(lds3, g, S, E); }
        GRID_BAR();
        ph_ln_rows(C, C.dout, C.dout, MTOK, C.lng + l * DMOD, C.lnb + l * DMOD, C.dout, C.HB);
        if (l == 0) GRID_BAR();
    }
}

extern "C" void kernel_launch(void* const* d_in, const int* in_sizes, int n_in, void* d_out, int out_size, void* d_ws, size_t ws_size, hipStream_t stream) {
    static int grid = 0;
    if (grid == 0) {
        if (n_in != 22 || out_size != MTOK * DMOD || ws_size < WS_END) { fprintf(stderr, "kernel_launch: unexpected shapes or workspace (%d inputs, out %d, ws %zu)\n", n_in, out_size, ws_size); grid = -1; return; }
        int dev = 0, cus = 0;
        if (hipGetDevice(&dev) != hipSuccess || hipDeviceGetAttribute(&cus, hipDeviceAttributeMultiprocessorCount, dev) != hipSuccess) { grid = -1; return; }
        if (hipFuncSetAttribute((const void*)fwd_megakernel, hipFuncAttributeMaxDynamicSharedMemorySize, LDS_BYTES) != hipSuccess) { fprintf(stderr, "kernel_launch: hipFuncSetAttribute failed\n"); grid = -1; return; }
        grid = cus;
    }
    if (grid < 0) return;
    if (hipMemsetAsync((char*)d_ws + WS_CTL, 0, CTL_ZERO_BYTES, stream) != hipSuccess) return;
    Args a{};
    for (int i = 0; i < 22; ++i) a.in[i] = (const float*)d_in[i];
    a.out = (float*)d_out; a.ws = (unsigned char*)d_ws;
    hipLaunchKernelGGL(fwd_megakernel, dim3(grid), dim3(NTHR), LDS_BYTES, stream, a);
}
```
